# Optimizing an MI355X kernel written in HIP

```python
import math
import jax, jax.numpy as jnp
from jax import lax
import numpy as np

D_MODEL = 2048
BATCH = 2
SEQ = 4096
DEPTH = 2

N_A_LAYERS = DEPTH // 2
N_B_LAYERS = DEPTH - N_A_LAYERS
GLA_HEADS = 4
GLA_KEY_DIM = D_MODEL // 2
GLA_VAL_DIM = D_MODEL
GLA_DK = GLA_KEY_DIM // GLA_HEADS
GLA_DV = GLA_VAL_DIM // GLA_HEADS
GATE_RANK = 16
GATE_NORMALIZER = 16.0
GLA_CHUNK = 64
GLA_IN_DIM = 2 * GLA_KEY_DIM + 2 * GLA_VAL_DIM + GATE_RANK
ATT_HEADS = 16
HEAD_DIM = D_MODEL // ATT_HEADS
WINDOWS = (128, 512, 2048)
DILATIONS = (1, 4, 16)
N_BRANCH = 3
ATT_BLOCK = 128
D_FF = 5632
CONV_WIDTH = 3
EPS = 1e-6

kernel_name = "yoco_gla_dilated_swa_convglu"


def rmsnorm(x, g):
    x32 = x.astype(jnp.float32)
    y = x32 * lax.rsqrt(jnp.mean(x32 * x32, axis=-1, keepdims=True) + EPS)
    return (y * g.astype(jnp.float32)).astype(x.dtype)


def alibi_slopes(n):
    def pow2_slopes(m):
        start = 2.0 ** (-8.0 / m)
        return [start ** (i + 1) for i in range(m)]
    if math.log2(n).is_integer():
        s = pow2_slopes(n)
    else:
        c = 2 ** math.floor(math.log2(n))
        s = pow2_slopes(c) + pow2_slopes(2 * c)[0::2][: n - c]
    return jnp.asarray(np.array(s, dtype=np.float32))


def gla_mixer(h, w_in, w_a2, b_a2, head_norm, w_out):
    bsz, s_len, _ = h.shape
    n_chunks = s_len // GLA_CHUNK
    f32 = jnp.float32
    proj = h @ w_in
    q, k, v, r, a = jnp.split(
        proj, [GLA_KEY_DIM, 2 * GLA_KEY_DIM, 2 * GLA_KEY_DIM + GLA_VAL_DIM,
               2 * GLA_KEY_DIM + 2 * GLA_VAL_DIM], axis=-1)
    log_alpha = jax.nn.log_sigmoid((a @ w_a2 + b_a2).astype(f32)) / GATE_NORMALIZER

    def chunks(t, hd):
        return t.astype(f32).reshape(bsz, n_chunks, GLA_CHUNK, GLA_HEADS, hd).transpose(1, 0, 3, 2, 4)

    qc = chunks(q, GLA_DK) * (GLA_DK ** -0.5)
    kc = chunks(k, GLA_DK)
    vc = chunks(v, GLA_DV)
    cum = jnp.cumsum(chunks(log_alpha, GLA_DK), axis=3)
    last = cum[:, :, :, -1:, :]
    q_dec = qc * jnp.exp(cum)
    k_inv = kc * jnp.exp(-cum)
    k_to_end = kc * jnp.exp(last - cum)

    causal = jnp.tril(jnp.ones((GLA_CHUNK, GLA_CHUNK), dtype=bool))
    scores = jnp.where(causal, jnp.einsum('nbhtk,nbhsk->nbhts', q_dec, k_inv), 0.0)
    o_intra = jnp.einsum('nbhts,nbhsv->nbhtv', scores, vc)

    def step(state, xs):
        q_n, k_n, v_n, dec_n = xs
        o_n = jnp.einsum('bhtk,bhkv->bhtv', q_n, state)
        state = state * dec_n[..., None] + jnp.einsum('bhsk,bhsv->bhkv', k_n, v_n)
        return state, o_n

    state0 = jnp.zeros((bsz, GLA_HEADS, GLA_DK, GLA_DV), f32)
    _, o_inter = lax.scan(step, state0, (q_dec, k_to_end, vc, jnp.exp(last[:, :, :, 0, :])))
    o = (o_intra + o_inter).transpose(1, 0, 3, 2, 4).reshape(bsz, s_len, GLA_HEADS, GLA_DV)
    o = rmsnorm(o, head_norm)
    gate = jax.nn.silu(r.astype(f32)).reshape(bsz, s_len, GLA_HEADS, GLA_DV)
    o = (o * gate).reshape(bsz, s_len, GLA_VAL_DIM).astype(h.dtype)
    return o @ w_out


def to_dilated(t, d):
    bsz, s_len, nh, e = t.shape
    return t.reshape(bsz, s_len // d, d, nh, e).transpose(0, 2, 1, 3, 4)


def n_blocks(sub_len):
    return -(-sub_len // ATT_BLOCK)


def to_query_blocks(t, d):
    td = to_dilated(t, d)
    bsz, _, sub_len, nh, e = td.shape
    nb = n_blocks(sub_len)
    td = jnp.pad(td, ((0, 0), (0, 0), (0, nb * ATT_BLOCK - sub_len), (0, 0), (0, 0)))
    return td.reshape(bsz, d, nb, ATT_BLOCK, nh, e)


def to_key_blocks(t, d):
    td = to_dilated(t, d)
    bsz, _, sub_len, nh, e = td.shape
    nb = n_blocks(sub_len)
    td = jnp.pad(td, ((0, 0), (0, 0), (ATT_BLOCK, nb * ATT_BLOCK - sub_len), (0, 0), (0, 0)))
    return td.reshape(bsz, d, nb + 1, ATT_BLOCK, nh, e)


def from_blocks(t, d, s_len):
    bsz, _, nb, _, nh, e = t.shape
    t = t.reshape(bsz, d, nb * ATT_BLOCK, nh, e)[:, :, : s_len // d]
    return t.transpose(0, 2, 1, 3, 4).reshape(bsz, s_len, nh, e)


def shared_kv(h, kv_norm, w_kv):
    bsz, s_len, _ = h.shape
    kv = rmsnorm(h, kv_norm) @ w_kv
    k, v = jnp.split(kv, 2, axis=-1)
    k = k.reshape(bsz, s_len, ATT_HEADS, HEAD_DIM)
    v = v.reshape(bsz, s_len, ATT_HEADS, HEAD_DIM)
    return [(to_key_blocks(k, d), to_key_blocks(v, d)) for d in DILATIONS]


def dilated_branch(qb, kb, vb, d, keys_back, slopes):
    nb = qb.shape[2]
    s_prev = jnp.einsum('brnqhe,brnkhe->brnhqk', qb, kb[:, :, :-1])
    s_cur = jnp.einsum('brnqhe,brnkhe->brnhqk', qb, kb[:, :, 1:])
    s = jnp.concatenate([s_prev, s_cur], axis=-1).astype(jnp.float32) * (HEAD_DIM ** -0.5)
    qa = jnp.arange(ATT_BLOCK)
    kc = jnp.arange(2 * ATT_BLOCK)
    j = qa[:, None] - kc[None, :] + ATT_BLOCK
    key_sub = jnp.arange(nb)[:, None] * ATT_BLOCK - ATT_BLOCK + kc[None, :]
    valid = ((j >= 0) & (j <= keys_back))[None] & (key_sub >= 0)[:, None, :]
    alibi = -slopes[:, None, None] * (j * d).astype(jnp.float32)[None]
    s = jnp.where(valid[None, None, :, None], s + alibi[None, None, None], -jnp.inf)
    m = jnp.max(s, axis=-1, keepdims=True)
    p = jnp.exp(s - m)
    l = jnp.sum(p, axis=-1, keepdims=True)
    o = (jnp.einsum('brnhqk,brnkhe->brnqhe', p[..., :ATT_BLOCK], vb[:, :, :-1])
         + jnp.einsum('brnhqk,brnkhe->brnqhe', p[..., ATT_BLOCK:], vb[:, :, 1:]))
    o = o / l.transpose(0, 1, 2, 4, 3, 5)
    lse = (m + jnp.log(l)).transpose(0, 1, 2, 4, 3, 5)
    return o, lse


def dilated_mixer(h, kv_blocks, w_q, w_out):
    bsz, s_len, _ = h.shape
    q = (h @ w_q).reshape(bsz, s_len, N_BRANCH, ATT_HEADS, HEAD_DIM)
    slopes = alibi_slopes(ATT_HEADS)
    outs, lses = [], []
    for g in range(N_BRANCH):
        d = DILATIONS[g]
        kb, vb = kv_blocks[g]
        o, lse = dilated_branch(to_query_blocks(q[:, :, g], d), kb, vb, d, WINDOWS[g] // d, slopes)
        outs.append(from_blocks(o, d, s_len))
        lses.append(from_blocks(lse, d, s_len))
    w = jax.nn.softmax(jnp.stack(lses, axis=0), axis=0)
    o = jnp.sum(w * jnp.stack(outs, axis=0), axis=0)
    return o.reshape(bsz, s_len, ATT_HEADS * HEAD_DIM).astype(h.dtype) @ w_out


def conv_glu(h, w_up, conv_w, conv_b, w_down):
    u, g = jnp.split(h @ w_up, 2, axis=-1)
    gp = jnp.pad(g, ((0, 0), (CONV_WIDTH - 1, 0), (0, 0)))
    g = conv_w[0] * gp[:, :-2] + conv_w[1] * gp[:, 1:-1] + conv_w[2] * gp[:, 2:] + conv_b
    return (jax.nn.gelu(g, approximate=False) * u) @ w_down


def setup_inputs(seed: int = 0) -> dict:
    key = jax.random.key(seed)
    ks = jax.random.split(key, 17)
    f32 = jnp.float32

    def nrm(k, shape, fan_in):
        return jax.random.normal(k, shape, f32) * (fan_in ** -0.5)

    def gain(k, shape):
        return 1.0 + 0.02 * jax.random.normal(k, shape, f32)

    return {
        "x": jax.random.normal(ks[0], (BATCH, SEQ, D_MODEL), f32),
        "attn_norm": gain(ks[1], (DEPTH, D_MODEL)),
        "gla_w_in": nrm(ks[2], (N_A_LAYERS, D_MODEL, GLA_IN_DIM), D_MODEL),
        "gla_w_a2": nrm(ks[3], (N_A_LAYERS, GATE_RANK, GLA_KEY_DIM), GATE_RANK),
        "gla_b_a2": 0.1 * jax.random.normal(ks[4], (N_A_LAYERS, GLA_KEY_DIM), f32),
        "gla_head_norm": gain(ks[5], (N_A_LAYERS, GLA_DV)),
        "gla_w_out": nrm(ks[6], (N_A_LAYERS, GLA_VAL_DIM, D_MODEL), GLA_VAL_DIM),
        "kv_norm": gain(ks[7], (D_MODEL,)),
        "w_kv": nrm(ks[8], (D_MODEL, 2 * ATT_HEADS * HEAD_DIM), D_MODEL),
        "dsa_w_q": nrm(ks[9], (N_B_LAYERS, D_MODEL, N_BRANCH * ATT_HEADS * HEAD_DIM), D_MODEL),
        "dsa_w_out": nrm(ks[10], (N_B_LAYERS, ATT_HEADS * HEAD_DIM, D_MODEL), ATT_HEADS * HEAD_DIM),
        "ffn_norm": gain(ks[11], (DEPTH, D_MODEL)),
        "ffn_w_up": nrm(ks[12], (DEPTH, D_MODEL, 2 * D_FF), D_MODEL),
        "ffn_conv_w": nrm(ks[13], (DEPTH, CONV_WIDTH, D_FF), CONV_WIDTH),
        "ffn_conv_b": 0.02 * jax.random.normal(ks[14], (DEPTH, D_FF), f32),
        "ffn_w_down": nrm(ks[15], (DEPTH, D_FF, D_MODEL), D_FF),
        "final_norm": gain(ks[16], (D_MODEL,)),
    }


def reference(x, attn_norm, gla_w_in, gla_w_a2, gla_b_a2, gla_head_norm, gla_w_out,
              kv_norm, w_kv, dsa_w_q, dsa_w_out, ffn_norm, ffn_w_up, ffn_conv_w,
              ffn_conv_b, ffn_w_down, final_norm):
    h = x
    kv_blocks = None
    for i in range(DEPTH):
        if i < N_A_LAYERS:
            h = h + gla_mixer(rmsnorm(h, attn_norm[i]), gla_w_in[i], gla_w_a2[i], gla_b_a2[i],
                              gla_head_norm[i], gla_w_out[i])
        else:
            if i == N_A_LAYERS:
                kv_blocks = shared_kv(h, kv_norm, w_kv)
            j = i - N_A_LAYERS
            h = h + dilated_mixer(rmsnorm(h, attn_norm[i]), kv_blocks, dsa_w_q[j], dsa_w_out[j])
        h = h + conv_glu(rmsnorm(h, ffn_norm[i]), ffn_w_up[i], ffn_conv_w[i], ffn_conv_b[i],
                         ffn_w_down[i])
    return rmsnorm(h, final_norm)
```

```cpp
#include <hip/hip_runtime.h>
#include <hip/hip_cooperative_groups.h>
#include <cstdio>
namespace cg = cooperative_groups;

#ifndef MK_ONE_LAUNCH
#define MK_ONE_LAUNCH 1
#endif

#define LAS __attribute__((address_space(3)))
typedef unsigned short bf16_t;
typedef short bf16x8 __attribute__((ext_vector_type(8)));
typedef short s16x4 __attribute__((ext_vector_type(4)));
typedef float f32x4 __attribute__((ext_vector_type(4)));
typedef unsigned u32x4 __attribute__((ext_vector_type(4)));
typedef unsigned u32x2 __attribute__((ext_vector_type(2)));

typedef __bf16 hwbf16x2 __attribute__((ext_vector_type(2)));
typedef float f32x2 __attribute__((ext_vector_type(2)));
__device__ __forceinline__ bf16_t f2bf(float f) { const __bf16 b = (__bf16)f; return __builtin_bit_cast(bf16_t, b); }
__device__ __forceinline__ float bf2f(bf16_t b) { return __uint_as_float(((unsigned)b) << 16); }
__device__ __forceinline__ unsigned pack2(float lo, float hi) { const f32x2 v = {lo, hi}; const hwbf16x2 b = __builtin_convertvector(v, hwbf16x2); return __builtin_bit_cast(unsigned, b); }
__device__ __forceinline__ float bflo(unsigned u) { return __uint_as_float(u << 16); }
__device__ __forceinline__ float bfhi(unsigned u) { return __uint_as_float(u & 0xFFFF0000u); }
#define LDS_BARRIER() do { asm volatile("s_waitcnt lgkmcnt(0)" ::: "memory"); __builtin_amdgcn_s_barrier(); asm volatile("" ::: "memory"); } while (0)
__device__ __forceinline__ float wave_sum(float v) {
#pragma unroll
    for (int o = 32; o > 0; o >>= 1) v += __shfl_xor(v, o);
    return v;
}

#define XB_TMO      128
#define XB_XCNT(j)  (256  + 64 * (j))
#define XB_XSUB(j)  (1280 + 64 * (j))
#define XB_XGEN(j)  (2304 + 64 * (j))
#define XB_TOP      3328
#define XB_TOPGEN   3392
#define XCD_BAR_WORDS 3456
#define XB_SPIN_CAP (1u << 18)
__device__ __forceinline__ unsigned xb_ld(unsigned* p)              { return __hip_atomic_load(p, __ATOMIC_RELAXED, __HIP_MEMORY_SCOPE_AGENT); }
__device__ __forceinline__ unsigned xb_add(unsigned* p, unsigned v) { return __hip_atomic_fetch_add(p, v, __ATOMIC_RELAXED, __HIP_MEMORY_SCOPE_AGENT); }
__device__ __forceinline__ unsigned xb_xcc_id() { return (unsigned)__builtin_amdgcn_s_getreg((3 << 11) | 20) & 0xFu; }
#define XB_SPIN(cond, bar) do { unsigned _sp = 0; while (cond) { __builtin_amdgcn_s_sleep(1); \
    if ((++_sp & 255u) == 0u) { if (xb_ld(&(bar)[XB_TMO])) break; if (_sp > XB_SPIN_CAP) { atomicAdd(&(bar)[XB_TMO], 1u); break; } } } } while (0)
struct XcdBarrier { unsigned* bar; unsigned x; volatile LAS unsigned* st; };
__device__ __forceinline__ XcdBarrier xcd_barrier_post(unsigned* bar, volatile LAS unsigned* st) {
    XcdBarrier b; b.bar = bar; b.x = xb_xcc_id(); b.st = st;
    if (threadIdx.x == 0) (void)xb_add(&bar[XB_XCNT(b.x)], 1u);
    return b;
}
__device__ __forceinline__ void xcd_barrier_complete(unsigned* bar, unsigned x, unsigned& nloc, unsigned& nx) {
    const unsigned G = gridDim.x * gridDim.y * gridDim.z;
    unsigned sum, cnt, mine, sp = 0u;
    for (;;) {
        sum = 0u; cnt = 0u; mine = 0u;
#pragma unroll
        for (unsigned j = 0; j < 16; ++j) { const unsigned c = xb_ld(&bar[XB_XCNT(j)]); sum += c; cnt += (c > 0u) ? 1u : 0u; mine = (j == x) ? c : mine; }
        if (sum == G) break;
        __builtin_amdgcn_s_sleep(1);
        if ((++sp & 255u) == 0u) { if (xb_ld(&bar[XB_TMO])) break; if (sp > XB_SPIN_CAP) { atomicAdd(&bar[XB_TMO], 1u); break; } }
    }
    nloc = mine > 0u ? mine : 1u; nx = cnt > 0u ? cnt : 1u;
}
__device__ __forceinline__ void xcd_barrier(const XcdBarrier& b) {
    asm volatile("s_waitcnt vmcnt(0)" ::: "memory");
    __syncthreads();
    if (threadIdx.x == 0) {
        unsigned* bar = b.bar;
        __builtin_amdgcn_s_waitcnt(0);
        unsigned nloc = b.st[0], nx = b.st[1];
        if (nloc == 0u) { xcd_barrier_complete(bar, b.x, nloc, nx); b.st[0] = nloc; b.st[1] = nx; }
        const unsigned old = xb_add(&bar[XB_XSUB(b.x)], 1u);
        const unsigned gen = old / nloc;
        if (old + 1u == (gen + 1u) * nloc) {
            __builtin_amdgcn_fence(__ATOMIC_RELEASE, "agent");
            asm volatile("s_waitcnt vmcnt(0)" ::: "memory");
            const unsigned og = xb_add(&bar[XB_TOP], 1u);
            const unsigned tg = og / nx;
            if (og + 1u == (tg + 1u) * nx) xb_add(&bar[XB_TOPGEN], 1u);
            else XB_SPIN(xb_ld(&bar[XB_TOPGEN]) == tg, bar);
            __builtin_amdgcn_fence(__ATOMIC_ACQUIRE, "agent");
            xb_add(&bar[XB_XGEN(b.x)], 1u);
            asm volatile("s_waitcnt vmcnt(0)" ::: "memory");
        } else {
            XB_SPIN(xb_ld(&bar[XB_XGEN(b.x)]) == gen, bar);
            __builtin_amdgcn_fence(__ATOMIC_ACQUIRE, "agent");
            asm volatile("s_waitcnt vmcnt(0)" ::: "memory");
        }
    }
    __syncthreads();
}

namespace pg8 {
constexpr int BM = 256, BK = 64, HALF = 128, HTB = HALF * BK * 2, STAGE_BYTES = 8 * HTB, NXCD = 8, WGM = 8;
__device__ __forceinline__ int lds_byte(int r, int c) { const int st = (r >> 4) * 2 + (c >> 5), rr = r & 15, cc = c & 31, ob = rr * 64 + cc * 2; return st * 1024 + (ob ^ (((ob >> 9) & 1) << 5)); }
__device__ __forceinline__ void stage_rc(int b, int& R, int& C) { const int st = b / 1024, sb = b % 1024, swz = sb ^ (((sb >> 9) & 1) << 5); R = (st >> 1) * 16 + swz / 64; C = (st & 1) * 32 + (swz % 64) / 2; }
__device__ __forceinline__ int perm32(int rho) { const int n = rho >> 4, i = rho & 15; return 8 * (i >> 2) + 4 * n + (i & 3); }
struct Unit { int pm, pn; };
struct Gemm { const bf16_t* A; const bf16_t* Bt; int M, N, K; };
struct StaticOrder {
    int nM, nN, nwg, G, c;
    __device__ void init(int M, int N, int G_, int c_) { nM = M / BM; nN = N / BM; nwg = nM * nN; G = G_; c = c_; }
    __device__ bool next(int i, Unit& u) const {
        const long L = (long)i * G + c; if (L >= nwg) return false;
        int wgid = (int)L; { const int q = nwg / NXCD, r = nwg % NXCD, xcd = wgid % NXCD, off = wgid / NXCD; wgid = (xcd < r ? xcd * (q + 1) : r * (q + 1) + (xcd - r) * q) + off; }
        const int nig = WGM * nN, gid = wgid / nig, fm = gid * WGM, gsz = (nM - fm) < WGM ? (nM - fm) : WGM;
        u.pm = fm + ((wgid % nig) % gsz); u.pn = (wgid % nig) / gsz; return true;
    }
    __device__ __forceinline__ void a_ready(const Unit&) const {}
    __device__ __forceinline__ void done(const Unit&) const {}
};

template <class Epi, class Sched, bool ALIGN_EPI = false, bool SP2 = false>
__device__ __forceinline__ void gemm_phase(LAS unsigned char* lds, const Gemm g, const Sched& S, const Epi& E) {
    const int tid = threadIdx.x, wid = __builtin_amdgcn_readfirstlane(tid >> 6), lane = tid & 63, wr = wid >> 2, wc = wid & 3, fr = lane & 15, fq = lane >> 4;
    const int K = g.K, nt = K / BK;
    unsigned voffA[2], voffB[2];
#pragma unroll
    for (int i = 0; i < 2; ++i) { int R, C; stage_rc(tid * 16 + i * 8192, R, C); const int Rb = Epi::PERM ? ((R & ~31) + perm32(R & 31)) : R;
        voffA[i] = (unsigned)(R * K + C) * 2u; voffB[i] = (unsigned)(Rb * K + C) * 2u; }
    const size_t kstep = (size_t)(BK * 2);
    const size_t hstep = (size_t)HALF * K * 2;
    const size_t tstep = 2 * hstep;
    const unsigned ldsw = (unsigned)wid * 1024u;
    const int aoff = lds_byte(wr * 64 + fr, fq * 8), boff = lds_byte(wc * 32 + fr, fq * 8);
#define PG8_SA(b, h) (((b) * 2 + (h)) * HTB)
#define PG8_SB(b, h) ((4 + (b) * 2 + (h)) * HTB)
#define PG8_STAGE(bufoff, gbase, voff) do { _Pragma("unroll") for (int _i = 0; _i < 2; ++_i) \
        __builtin_amdgcn_global_load_lds((const unsigned*)((const char*)(gbase) + (voff)[_i]), (LAS unsigned*)(lds + (bufoff) + ldsw + _i * 8192), 16, 0, 0); } while (0)
#define PG8_LDA(dst, b, h) do { _Pragma("unroll") for (int m = 0; m < 4; ++m) _Pragma("unroll") for (int k = 0; k < 2; ++k) dst[m][k] = *(const LAS bf16x8*)(lds + PG8_SA(b, h) + aoff + m * 2048 + k * 1024); } while (0)
#define PG8_LDB(dst, b, h) do { _Pragma("unroll") for (int n = 0; n < 2; ++n) _Pragma("unroll") for (int k = 0; k < 2; ++k) dst[n][k] = *(const LAS bf16x8*)(lds + PG8_SB(b, h) + boff + n * 2048 + k * 1024); } while (0)
#define PG8_MMA(ai, bj, At, Bt) do { __builtin_amdgcn_s_setprio(1); _Pragma("unroll") for (int m = 0; m < 4; ++m) _Pragma("unroll") for (int n = 0; n < 2; ++n) _Pragma("unroll") for (int k = 0; k < 2; ++k) \
        acc[ai][bj][m][n] = __builtin_amdgcn_mfma_f32_16x16x32_bf16(Bt[n][k], At[m][k], acc[ai][bj][m][n], 0, 0, 0); __builtin_amdgcn_s_setprio(0); } while (0)
#define PG8_WAIT_V(n) asm volatile("s_waitcnt vmcnt(" #n ")" ::: "memory")
#define PG8_WAIT_L(n) asm volatile("s_waitcnt lgkmcnt(" #n ")" ::: "memory")
#define PG8_BAR __builtin_amdgcn_s_barrier()
#define PG8_SCHED __builtin_amdgcn_sched_barrier(0)
    Unit cur, nxt; int ui = 0;
    if (!S.next(0, cur)) return;
    f32x4 acc[2][2][4][2];
#pragma unroll
    for (int a = 0; a < 2; ++a)
#pragma unroll
        for (int b = 0; b < 2; ++b)
#pragma unroll
            for (int m = 0; m < 4; ++m)
#pragma unroll
                for (int n = 0; n < 2; ++n) acc[a][b][m][n] = (f32x4){0.f, 0.f, 0.f, 0.f};
    bf16x8 At[4][2], B0[2][2], B1[2][2];
    const char* cA = (const char*)g.A + (size_t)cur.pm * tstep; const char* cB = (const char*)g.Bt + (size_t)cur.pn * tstep;
    S.a_ready(cur);
    if constexpr (SP2) {
        PG8_STAGE(PG8_SB(0, 0), cB, voffB); PG8_STAGE(PG8_SB(0, 1), cB + hstep, voffB); PG8_STAGE(PG8_SA(0, 0), cA, voffA); PG8_STAGE(PG8_SA(0, 1), cA + hstep, voffA);
        if (wr == 1) PG8_BAR;
        PG8_WAIT_V(2); PG8_BAR;
        PG8_STAGE(PG8_SB(1, 0), cB + kstep, voffB); PG8_STAGE(PG8_SA(1, 0), cA + kstep, voffA); PG8_STAGE(PG8_SB(1, 1), cB + hstep + kstep, voffB);
        PG8_WAIT_V(6); PG8_BAR;
    } else {
        PG8_STAGE(PG8_SB(0, 0), cB, voffB); PG8_STAGE(PG8_SA(0, 0), cA, voffA); PG8_STAGE(PG8_SB(0, 1), cB + hstep, voffB); PG8_STAGE(PG8_SA(0, 1), cA + hstep, voffA);
        if (wr == 1) PG8_BAR;
        PG8_WAIT_V(4); PG8_BAR;
        PG8_STAGE(PG8_SB(1, 0), cB + kstep, voffB); PG8_STAGE(PG8_SA(1, 0), cA + kstep, voffA); PG8_STAGE(PG8_SB(1, 1), cB + hstep + kstep, voffB);
        PG8_WAIT_V(6); PG8_BAR;
    }
    for (;;) {
        const bool has_next = S.next(ui + 1, nxt);
        const char* nA = has_next ? (const char*)g.A + (size_t)nxt.pm * tstep : cA; const char* nB = has_next ? (const char*)g.Bt + (size_t)nxt.pn * tstep : cB;
        for (int t = 0; t < nt; t += 2) {
            const bool last = (t == nt - 2);
            const char* a1 = cA + (size_t)(t + 1) * kstep;
            const char* a2 = last ? nA : cA + (size_t)(t + 2) * kstep; const char* b2 = last ? nB : cB + (size_t)(t + 2) * kstep;
            const char* a3 = a2 + kstep; const char* b3 = b2 + kstep;
            if (last && has_next) S.a_ready(nxt);
            if constexpr (SP2) {
            PG8_LDB(B0, 0, 0); PG8_LDB(B1, 0, 1); PG8_SCHED; PG8_LDA(At, 0, 0); PG8_STAGE(PG8_SA(1, 1), a1 + hstep, voffA);
            PG8_WAIT_V(8); PG8_WAIT_L(0); PG8_BAR; PG8_MMA(0, 0, At, B0); PG8_MMA(0, 1, At, B1); PG8_BAR; PG8_SCHED;
            PG8_LDA(At, 0, 1); PG8_STAGE(PG8_SB(0, 0), b2, voffB); PG8_STAGE(PG8_SB(0, 1), b2 + hstep, voffB); PG8_STAGE(PG8_SA(0, 0), a2, voffA);
            PG8_WAIT_V(8); PG8_WAIT_L(0); PG8_BAR; PG8_MMA(1, 0, At, B0); PG8_MMA(1, 1, At, B1); PG8_BAR; PG8_SCHED;
            PG8_LDB(B0, 1, 0); PG8_LDB(B1, 1, 1); PG8_SCHED; PG8_LDA(At, 1, 0); PG8_STAGE(PG8_SA(0, 1), a2 + hstep, voffA);
            PG8_WAIT_V(8); PG8_WAIT_L(0); PG8_BAR; PG8_MMA(0, 0, At, B0); PG8_MMA(0, 1, At, B1); PG8_BAR; PG8_SCHED;
            PG8_LDA(At, 1, 1); PG8_STAGE(PG8_SB(1, 0), b3, voffB); PG8_STAGE(PG8_SB(1, 1), b3 + hstep, voffB); PG8_STAGE(PG8_SA(1, 0), a3, voffA);
            PG8_WAIT_V(8); PG8_WAIT_L(0); PG8_BAR; PG8_MMA(1, 0, At, B0); PG8_MMA(1, 1, At, B1); PG8_BAR; PG8_SCHED;
            } else {
            PG8_LDB(B0, 0, 0); PG8_SCHED; PG8_LDA(At, 0, 0); PG8_STAGE(PG8_SA(1, 1), a1 + hstep, voffA);
            PG8_WAIT_L(8); PG8_BAR; PG8_WAIT_L(0); PG8_MMA(0, 0, At, B0); PG8_BAR; PG8_SCHED;
            PG8_LDB(B1, 0, 1); PG8_STAGE(PG8_SB(0, 0), b2, voffB);
            PG8_BAR; PG8_WAIT_L(0); PG8_MMA(0, 1, At, B1); PG8_BAR;
            PG8_LDA(At, 0, 1); PG8_STAGE(PG8_SA(0, 0), a2, voffA);
            PG8_BAR; PG8_WAIT_L(0); PG8_MMA(1, 0, At, B0); PG8_BAR; PG8_SCHED;
            PG8_STAGE(PG8_SB(0, 1), b2 + hstep, voffB);
            PG8_WAIT_V(6); PG8_BAR; PG8_MMA(1, 1, At, B1); PG8_BAR;
            PG8_LDB(B0, 1, 0); PG8_SCHED; PG8_LDA(At, 1, 0); PG8_STAGE(PG8_SA(0, 1), a2 + hstep, voffA);
            PG8_WAIT_L(8); PG8_BAR; PG8_WAIT_L(0); PG8_MMA(0, 0, At, B0); PG8_BAR; PG8_SCHED;
            PG8_LDB(B1, 1, 1); PG8_STAGE(PG8_SB(1, 0), b3, voffB);
            PG8_BAR; PG8_WAIT_L(0); PG8_MMA(0, 1, At, B1); PG8_BAR;
            PG8_LDA(At, 1, 1); PG8_STAGE(PG8_SA(1, 0), a3, voffA);
            PG8_BAR; PG8_WAIT_L(0); PG8_MMA(1, 0, At, B0); PG8_BAR; PG8_SCHED;
            PG8_STAGE(PG8_SB(1, 1), b3 + hstep, voffB);
            PG8_WAIT_V(6); PG8_BAR; PG8_MMA(1, 1, At, B1); PG8_BAR;
            }
        }
        if constexpr (ALIGN_EPI) { if (wr == 0) PG8_BAR; }
        if constexpr (!Epi::AFTER_DRAIN) { E(acc, cur, wr, wc, fr, fq); S.done(cur); }
        if (!has_next) break;
#pragma unroll
        for (int a = 0; a < 2; ++a)
#pragma unroll
            for (int b = 0; b < 2; ++b)
#pragma unroll
                for (int m = 0; m < 4; ++m)
#pragma unroll
                    for (int n = 0; n < 2; ++n) acc[a][b][m][n] = (f32x4){0.f, 0.f, 0.f, 0.f};
        cur = nxt; cA = nA; cB = nB; ++ui;
        if constexpr (ALIGN_EPI) { if (wr == 1) PG8_BAR; }
    }
    PG8_WAIT_V(0);
    if constexpr (!ALIGN_EPI) { if (wr == 0) PG8_BAR; }
    PG8_BAR;
    if constexpr (Epi::AFTER_DRAIN) { E.fused(acc, cur, wr, wc, fr, fq, lds, wid, lane); S.done(cur); }
#undef PG8_SA
#undef PG8_SB
#undef PG8_STAGE
#undef PG8_LDA
#undef PG8_LDB
#undef PG8_MMA
#undef PG8_WAIT_V
#undef PG8_WAIT_L
#undef PG8_BAR
#undef PG8_SCHED
}
}

struct EpiScaleBf16 {
    static constexpr bool PERM = true, AFTER_DRAIN = false;
    bf16_t* O; int ldo; const float* rstd; int nvalid; float* aout;
    __device__ __forceinline__ void operator()(const f32x4 (&acc)[2][2][4][2], const pg8::Unit& u, int wr, int wc, int fr, int fq) const {
        const int row0 = u.pm * 256 + wr * 64 + fr, colb = u.pn * 256 + wc * 32 + 8 * fq;
#pragma unroll
        for (int ai = 0; ai < 2; ++ai)
#pragma unroll
            for (int m = 0; m < 4; ++m) {
                const int r = row0 + ai * 128 + m * 16; const float s = rsqrtf(rstd[r] * (1.f / 2048.f) + 1e-6f);
#pragma unroll
                for (int bj = 0; bj < 2; ++bj) {
                    const int c = colb + bj * 128; const f32x4 v0 = acc[ai][bj][m][0] * s, v1 = acc[ai][bj][m][1] * s;
                    if (c < nvalid) { u32x4 pk = {pack2(v0[0], v0[1]), pack2(v0[2], v0[3]), pack2(v1[0], v1[1]), pack2(v1[2], v1[3])}; *(u32x4*)(O + (size_t)r * ldo + c) = pk; }
                    else if (aout && c < nvalid + 16) { float* ap = aout + (size_t)r * 16 + (c - nvalid); *(f32x4*)ap = v0; *(f32x4*)(ap + 4) = v1; }
                }
            }
    }
};
struct EpiNull { static constexpr bool PERM = true, AFTER_DRAIN = false; float* sink;
    __device__ __forceinline__ void operator()(const f32x4 (&acc)[2][2][4][2], const pg8::Unit& u, int wr, int wc, int fr, int fq) const {
        float t = 0.f;
#pragma unroll
        for (int ai = 0; ai < 2; ++ai)
#pragma unroll
            for (int bj = 0; bj < 2; ++bj)
#pragma unroll
                for (int m = 0; m < 4; ++m)
#pragma unroll
                    for (int n = 0; n < 2; ++n) t += acc[ai][bj][m][n][0] + acc[ai][bj][m][n][1] + acc[ai][bj][m][n][2] + acc[ai][bj][m][n][3];
        if (t == 1.2345e30f) sink[0] = t;
    } };
template <bool BASE_BF16> struct EpiResid {
    static constexpr bool PERM = false, AFTER_DRAIN = false;
    const void* base; float* out;
    __device__ __forceinline__ void operator()(const f32x4 (&acc)[2][2][4][2], const pg8::Unit& u, int wr, int wc, int fr, int fq) const {
        const int row0 = u.pm * 256 + wr * 64 + fr, col0 = u.pn * 256 + wc * 32 + 4 * fq;
#pragma unroll
        for (int ai = 0; ai < 2; ++ai)
#pragma unroll
            for (int mp = 0; mp < 2; ++mp) {
                f32x4 bv[2][2][2];
#pragma unroll
                for (int mm = 0; mm < 2; ++mm)
#pragma unroll
                    for (int bj = 0; bj < 2; ++bj)
#pragma unroll
                        for (int n = 0; n < 2; ++n) { const size_t idx = (size_t)(row0 + ai * 128 + (mp * 2 + mm) * 16) * 2048 + col0 + bj * 128 + n * 16;
                            if (BASE_BF16) { const u32x2 t = *(const u32x2*)((const bf16_t*)base + idx); bv[mm][bj][n] = (f32x4){bflo(t[0]), bfhi(t[0]), bflo(t[1]), bfhi(t[1])}; }
                            else bv[mm][bj][n] = *(const f32x4*)((const float*)base + idx); }
#pragma unroll
                for (int mm = 0; mm < 2; ++mm)
#pragma unroll
                    for (int bj = 0; bj < 2; ++bj)
#pragma unroll
                        for (int n = 0; n < 2; ++n) *(f32x4*)(out + (size_t)(row0 + ai * 128 + (mp * 2 + mm) * 16) * 2048 + col0 + bj * 128 + n * 16) = bv[mm][bj][n] + acc[ai][bj][mp * 2 + mm][n];
            }
    }
};
template <bool BASE_BF16> struct EpiResidNorm {
    static constexpr bool PERM = false, AFTER_DRAIN = false;
    const void* base; bf16_t* xb; float* sumsq;
    __device__ __forceinline__ void operator()(const f32x4 (&acc)[2][2][4][2], const pg8::Unit& u, int wr, int wc, int fr, int fq) const {
        const int row0 = u.pm * 256 + wr * 64 + fr, col0 = u.pn * 256 + wc * 32 + 4 * fq;
#pragma unroll
        for (int ai = 0; ai < 2; ++ai)
#pragma unroll
            for (int mp = 0; mp < 2; ++mp) {
                f32x4 bv[2][2][2];
#pragma unroll
                for (int mm = 0; mm < 2; ++mm)
#pragma unroll
                    for (int bj = 0; bj < 2; ++bj)
#pragma unroll
                        for (int n = 0; n < 2; ++n) { const size_t idx = (size_t)(row0 + ai * 128 + (mp * 2 + mm) * 16) * 2048 + col0 + bj * 128 + n * 16;
                            if (BASE_BF16) { const u32x2 t = *(const u32x2*)((const bf16_t*)base + idx); bv[mm][bj][n] = (f32x4){bflo(t[0]), bfhi(t[0]), bflo(t[1]), bfhi(t[1])}; }
                            else bv[mm][bj][n] = *(const f32x4*)((const float*)base + idx); }
#pragma unroll
                for (int mm = 0; mm < 2; ++mm) {
                    const int r = row0 + ai * 128 + (mp * 2 + mm) * 16; float ss = 0.f;
#pragma unroll
                    for (int bj = 0; bj < 2; ++bj)
#pragma unroll
                        for (int n = 0; n < 2; ++n) { const size_t idx = (size_t)r * 2048 + col0 + bj * 128 + n * 16; const f32x4 v = bv[mm][bj][n] + acc[ai][bj][mp * 2 + mm][n];
                            u32x2 pk = {pack2(v[0], v[1]), pack2(v[2], v[3])}; *(u32x2*)(xb + idx) = pk; ss += v[0] * v[0] + v[1] * v[1] + v[2] * v[2] + v[3] * v[3]; }
                    ss += __shfl_xor(ss, 16); ss += __shfl_xor(ss, 32);
                    if (fq == 0) __hip_atomic_fetch_add(sumsq + r, ss, __ATOMIC_RELAXED, __HIP_MEMORY_SCOPE_AGENT);
                }
            }
    }
};

constexpr int NTOK = 8192, DM = 2048, SEQ = 4096, DFF = 5632, NIN = 6160, NINP = 6400;
constexpr int LDS_BYTES = 147456;
constexpr size_t al256(size_t x) { return (x + 255) & ~(size_t)255; }
constexpr size_t OFF_WT_IN = 0;
constexpr size_t OFF_WT_GOUT = OFF_WT_IN + al256((size_t)NINP * DM * 2);
constexpr size_t OFF_WT_UP0 = OFF_WT_GOUT + al256((size_t)DM * DM * 2);
constexpr size_t OFF_WT_UP1 = OFF_WT_UP0 + al256((size_t)2 * DFF * DM * 2);
constexpr size_t OFF_WT_DN0 = OFF_WT_UP1 + al256((size_t)2 * DFF * DM * 2);
constexpr size_t OFF_WT_DN1 = OFF_WT_DN0 + al256((size_t)DM * DFF * 2);
constexpr size_t OFF_WT_KVQ = OFF_WT_DN1 + al256((size_t)DM * DFF * 2);
constexpr size_t OFF_WT_AOUT = OFF_WT_KVQ + al256((size_t)10240 * DM * 2);
constexpr size_t OFF_XB = OFF_WT_AOUT + al256((size_t)DM * DM * 2);
constexpr size_t OFF_OG = OFF_XB + al256((size_t)NTOK * DM * 2);
constexpr size_t OFF_RSTD = OFF_OG + al256((size_t)NTOK * DM * 2);
constexpr size_t OFF_AG = OFF_RSTD + al256((size_t)4 * NTOK * 4);
constexpr size_t OFF_DEC = OFF_AG + al256((size_t)NTOK * 16 * 4);
constexpr size_t OFF_LSE = OFF_DEC + al256((size_t)512 * 256 * 4);
constexpr size_t OFF_BAR = OFF_LSE + al256((size_t)3 * NTOK * 16 * 4);
constexpr size_t OFF_R1 = OFF_BAR + al256((size_t)XCD_BAR_WORDS * 4);
constexpr size_t OFF_R2 = OFF_R1 + al256((size_t)NTOK * 2 * DFF * 2);
constexpr size_t OFF_OGLA = OFF_R2;
constexpr size_t OFF_QD = OFF_OGLA + al256((size_t)NTOK * DM * 4);
constexpr size_t OFF_KTE = OFF_QD + al256((size_t)NTOK * 1024 * 2);
constexpr size_t OFF_PSC = OFF_KTE + al256((size_t)NTOK * 1024 * 2);
constexpr size_t R2_GLA_END = OFF_PSC + al256((size_t)512 * 4096 * 2);
constexpr size_t OFF_ACT = OFF_R2;
constexpr size_t OFF_ATTO = OFF_R2;
constexpr size_t R2_SIZE = (R2_GLA_END - OFF_R2) > (size_t)3 * NTOK * DM * 2 ? (R2_GLA_END - OFF_R2) : (size_t)3 * NTOK * DM * 2;
constexpr size_t WS_END = OFF_R2 + R2_SIZE;

struct P {
    const float* x; const float* attn_norm; const float* gla_w_in; const float* gla_w_a2; const float* gla_b_a2; const float* gla_head_norm; const float* gla_w_out;
    const float* kv_norm; const float* w_kv; const float* dsa_w_q; const float* dsa_w_out; const float* ffn_norm; const float* ffn_w_up; const float* ffn_conv_w;
    const float* ffn_conv_b; const float* ffn_w_down; const float* final_norm;
    float* out; unsigned char* ws; int ph_lo, ph_hi;
};

__device__ __forceinline__ void convert_job(const float* __restrict__ W, int ldw, int K, int N, const float* __restrict__ gain, bf16_t* __restrict__ Wt, int& g, int& base, LAS unsigned char* lds) {
    const int nkb = K / 128, ntiles = (N / 64) * nkb;
    const int tid = threadIdx.x;
    LAS bf16_t* T = (LAS bf16_t*)lds;
    const int n4 = tid & 15, kr = tid >> 4;
    while (g < base + ntiles) {
        const int t = g - base; const int nb = t / nkb, kb = t - nb * nkb;
        const int n0 = nb * 64, k0 = kb * 128;
        f32x4 v[4]; float gn[4];
#pragma unroll
        for (int q = 0; q < 4; ++q) { const int k = k0 + kr + 32 * q; v[q] = *(const f32x4*)(W + (size_t)k * ldw + n0 + n4 * 4); gn[q] = gain ? gain[k] : 1.f; }
#pragma unroll
        for (int q = 0; q < 4; ++q)
#pragma unroll
            for (int j = 0; j < 4; ++j) T[(n4 * 4 + j) * 136 + kr + 32 * q] = f2bf(v[q][j] * gn[q]);
        __syncthreads();
#pragma unroll
        for (int q = 0; q < 2; ++q) { const int c = tid + 512 * q; const int n = c >> 4, kc = c & 15; const u32x4 dd = *(const LAS u32x4*)(T + n * 136 + kc * 8); *(u32x4*)(Wt + (size_t)(n0 + n) * K + k0 + kc * 8) = dd; }
        __syncthreads();
        g += gridDim.x;
    }
    base += ntiles;
}

__device__ __forceinline__ void norm_pass(const float* __restrict__ src, bf16_t* __restrict__ dst, float* __restrict__ rstd) {
    const int lane = threadIdx.x & 63, wave = threadIdx.x >> 6;
    const int row0 = blockIdx.x * 8 + wave, rstep = gridDim.x * 8;
    f32x4 nv[8];
#pragma unroll
    for (int i = 0; i < 8; ++i) nv[i] = (f32x4){0.f, 0.f, 0.f, 0.f};
    if (row0 < NTOK) {
#pragma unroll
        for (int i = 0; i < 8; ++i) nv[i] = __builtin_nontemporal_load((const f32x4*)(src + (size_t)row0 * DM + (i * 64 + lane) * 4));
    }
    for (int row = row0; row < NTOK; row += rstep) {
        f32x4 v[8]; float ss = 0.f;
#pragma unroll
        for (int i = 0; i < 8; ++i) { v[i] = nv[i]; ss += v[i][0] * v[i][0] + v[i][1] * v[i][1] + v[i][2] * v[i][2] + v[i][3] * v[i][3]; }
        if (row + rstep < NTOK) {
#pragma unroll
            for (int i = 0; i < 8; ++i) nv[i] = __builtin_nontemporal_load((const f32x4*)(src + (size_t)(row + rstep) * DM + (i * 64 + lane) * 4));
        }
        ss = wave_sum(ss);
        if (lane == 0) rstd[row] = ss;
#pragma unroll
        for (int i = 0; i < 8; ++i) { u32x2 pk = {pack2(v[i][0], v[i][1]), pack2(v[i][2], v[i][3])}; *(u32x2*)(dst + (size_t)row * DM + (i * 64 + lane) * 4) = pk; }
    }
}

__device__ __forceinline__ void final_norm_pass(float* h, const float* __restrict__ gain) {
    const int lane = threadIdx.x & 63, wave = threadIdx.x >> 6;
    const int row0 = blockIdx.x * 8 + wave, rstep = gridDim.x * 8;
    f32x4 gg[8], nv[8];
#pragma unroll
    for (int i = 0; i < 8; ++i) { gg[i] = *(const f32x4*)(gain + (i * 64 + lane) * 4); nv[i] = (f32x4){0.f, 0.f, 0.f, 0.f}; }
    if (row0 < NTOK) {
#pragma unroll
        for (int i = 0; i < 8; ++i) nv[i] = *(const f32x4*)(h + (size_t)row0 * DM + (i * 64 + lane) * 4);
    }
    for (int row = row0; row < NTOK; row += rstep) {
        float* s = h + (size_t)row * DM; f32x4 v[8]; float ss = 0.f;
#pragma unroll
        for (int i = 0; i < 8; ++i) { v[i] = nv[i]; ss += v[i][0] * v[i][0] + v[i][1] * v[i][1] + v[i][2] * v[i][2] + v[i][3] * v[i][3]; }
        if (row + rstep < NTOK) {
#pragma unroll
            for (int i = 0; i < 8; ++i) nv[i] = *(const f32x4*)(h + (size_t)(row + rstep) * DM + (i * 64 + lane) * 4);
        }
        ss = wave_sum(ss);
        const float rs = rsqrtf(ss * (1.f / DM) + 1e-6f);
#pragma unroll
        for (int i = 0; i < 8; ++i) *(f32x4*)(s + (i * 64 + lane) * 4) = v[i] * rs * gg[i];
    }
}

constexpr int CONV_BATCHES = (2 * (512 + 2816 + 1408) + 1024 + 1536) / 4;
__device__ __forceinline__ bool conv_locate(const P& p, int g, const float*& W, int& ldw, int& K, const float*& gain, bf16_t*& Wt, int& t) {
    unsigned char* ws = p.ws; int base = 0;
#define CJ(Wp, LDW, KK, NN, GP, DST) { const int nt_ = ((NN) / 128) * ((KK) / 256); if (g < base + nt_) { W = (Wp); ldw = (LDW); K = (KK); gain = (GP); Wt = (bf16_t*)(DST); t = g - base; return true; } base += nt_; }
    CJ(p.gla_w_out, DM, DM, DM, nullptr, ws + OFF_WT_GOUT)
    CJ(p.ffn_w_up, 2 * DFF, DM, 2 * DFF, p.ffn_norm, ws + OFF_WT_UP0)
    CJ(p.ffn_w_down, DM, DFF, DM, nullptr, ws + OFF_WT_DN0)
    CJ(p.w_kv, 4096, DM, 4096, p.kv_norm, ws + OFF_WT_KVQ)
    CJ(p.dsa_w_q, 6144, DM, 6144, p.attn_norm + DM, ws + OFF_WT_KVQ + (size_t)4096 * DM * 2)
    CJ(p.dsa_w_out, DM, DM, DM, nullptr, ws + OFF_WT_AOUT)
    CJ(p.ffn_w_up + (size_t)DM * 2 * DFF, 2 * DFF, DM, 2 * DFF, p.ffn_norm + DM, ws + OFF_WT_UP1)
    CJ(p.ffn_w_down + (size_t)DFF * DM, DM, DFF, DM, nullptr, ws + OFF_WT_DN1)
#undef CJ
    return false;
}

__device__ __forceinline__ int conv_nb2(const P& p, const float* W) {
    if (W == p.ffn_w_up || W == p.ffn_w_up + (size_t)DM * 2 * DFF) return 2 * DFF / 128;
    if (W == p.w_kv) return 4096 / 128;
    if (W == p.dsa_w_q) return 6144 / 128;
    return DM / 128;
}

__device__ __forceinline__ void phase_prologue(const P& p, LAS unsigned char* lds) {
    unsigned char* ws = p.ws;
    norm_pass(p.x, (bf16_t*)(ws + OFF_XB), (float*)(ws + OFF_RSTD));
    {
        bf16_t* wt = (bf16_t*)(ws + OFF_WT_IN);
        for (int i = blockIdx.x * 512 + threadIdx.x; i < 16 * DM; i += gridDim.x * 512) {
            const int j = i >> 11, k = i & 2047; const float v = p.gla_w_in[(size_t)k * NIN + 6144 + j] * p.attn_norm[k];
            wt[(size_t)(6144 + j) * DM + k] = f2bf(v);
        }
        float* ssz = (float*)(ws + OFF_RSTD) + NTOK;
        for (int i = blockIdx.x * 512 + threadIdx.x; i < 3 * NTOK; i += gridDim.x * 512) ssz[i] = 0.f;
    }
    int g = blockIdx.x, base = 0;
    convert_job(p.gla_w_in, NIN, DM, 6144, p.attn_norm, (bf16_t*)(ws + OFF_WT_IN), g, base, lds);
}

__device__ __forceinline__ void gla_prep(const P& p, LAS unsigned char* lds) {
    unsigned char* ws = p.ws;
    const bf16_t* PROJ = (const bf16_t*)(ws + OFF_R1); const bf16_t* XB = (const bf16_t*)(ws + OFF_XB); const bf16_t* WA = (const bf16_t*)(ws + OFF_WT_IN) + (size_t)6144 * DM; const float* SS0 = (const float*)(ws + OFF_RSTD);
    bf16_t* QD = (bf16_t*)(ws + OFF_QD); bf16_t* KTE = (bf16_t*)(ws + OFF_KTE); bf16_t* PSC = (bf16_t*)(ws + OFF_PSC); float* DEC = (float*)(ws + OFF_DEC);
    LAS bf16_t* sQ = (LAS bf16_t*)lds;
    LAS bf16_t* sK = sQ + 64 * 264;
    LAS float* sTot = (LAS float*)(lds + 2 * 64 * 264 * 2);
    LAS float* sAp = sTot + 512;
    LAS float* sAf = sAp + 2048;
    const int tid = threadIdx.x, kcol = tid & 255, half = __builtin_amdgcn_readfirstlane(tid >> 8);
    const int lane = tid & 63, wid = __builtin_amdgcn_readfirstlane(tid >> 6), fr = lane & 15, fq = lane >> 4;
    for (int item = blockIdx.x; item < 512; item += gridDim.x) {
        const int n = item & 63, h = (item >> 6) & 3, b = item >> 8;
        const int tok0 = b * SEQ + n * 64;
        {
            const int tt4 = wid & 3, kh = wid >> 2; f32x4 aacc = {0.f, 0.f, 0.f, 0.f};
            const bf16_t* arow = XB + (size_t)(tok0 + tt4 * 16 + fr) * DM + kh * 1024 + fq * 8;
            const bf16_t* brow = WA + (size_t)fr * DM + kh * 1024 + fq * 8;
            for (int kb0 = 0; kb0 < 32; kb0 += 16) {
                bf16x8 af[16], bfr[16];
#pragma unroll
                for (int i = 0; i < 16; ++i) { af[i] = *(const bf16x8*)(arow + (kb0 + i) * 32); bfr[i] = *(const bf16x8*)(brow + (kb0 + i) * 32); }
#pragma unroll
                for (int i = 0; i < 16; ++i) aacc = __builtin_amdgcn_mfma_f32_16x16x32_bf16(af[i], bfr[i], aacc, 0, 0, 0);
            }
#pragma unroll
            for (int j = 0; j < 4; ++j) sAp[kh * 1024 + (tt4 * 16 + 4 * fq + j) * 16 + fr] = aacc[j];
            __syncthreads();
#pragma unroll
            for (int q = 0; q < 2; ++q) { const int idx = tid + 512 * q; sAf[idx] = (sAp[idx] + sAp[1024 + idx]) * rsqrtf(SS0[tok0 + (idx >> 4)] * (1.f / 2048.f) + 1e-6f); }
            __syncthreads();
        }
        bf16_t qraw[32], kraw[32];
#pragma unroll
        for (int tt = 0; tt < 32; ++tt) { const size_t tok = (size_t)(tok0 + half * 32 + tt); qraw[tt] = __builtin_nontemporal_load(PROJ + tok * 6144 + h * 256 + kcol); kraw[tt] = __builtin_nontemporal_load(PROJ + tok * 6144 + 1024 + h * 256 + kcol); }
        float w2[16];
#pragma unroll
        for (int j = 0; j < 16; ++j) w2[j] = p.gla_w_a2[j * 1024 + h * 256 + kcol];
        const float bias = p.gla_b_a2[h * 256 + kcol];
        float cum[32]; float run = 0.f;
#pragma unroll
        for (int tt = 0; tt < 32; ++tt) {
            const LAS float* ap = sAf + (half * 32 + tt) * 16; float xg = bias;
#pragma unroll
            for (int j = 0; j < 16; ++j) xg += ap[j] * w2[j];
            const float ls = fminf(xg, 0.f) - __logf(1.f + __expf(-fabsf(xg)));
            run += ls * (1.f / 16.f); cum[tt] = run;
        }
        sTot[half * 256 + kcol] = run;
        __syncthreads();
        const float tot0 = sTot[kcol], tot1 = sTot[256 + kcol]; const float last = tot0 + tot1; const float off = half ? tot0 : 0.f;
        unsigned ktp[16];
#pragma unroll
        for (int tt = 0; tt < 32; ++tt) {
            const float c = cum[tt] + off; const int tok = tok0 + half * 32 + tt;
            const float q = bf2f(qraw[tt]); const float k = bf2f(kraw[tt]);
            const float qd = q * 0.0625f * __expf(c); const float ki = k * __expf(-c); const float kte = k * __expf(last - c);
            const bf16_t qb = f2bf(qd); QD[(((size_t)item * 8 + (kcol >> 5)) * 64 + half * 32 + tt) * 32 + (kcol & 31)] = qb;
            sQ[(half * 32 + tt) * 264 + kcol] = qb; sK[(half * 32 + tt) * 264 + kcol] = f2bf(ki);
            if (tt & 1) ktp[tt >> 1] |= ((unsigned)f2bf(kte)) << 16; else ktp[tt >> 1] = (unsigned)f2bf(kte);
        }
        {
            u32x4* dst = (u32x4*)(KTE + ((size_t)item * 256 + kcol) * 64 + half * 32);
#pragma unroll
            for (int i = 0; i < 4; ++i) { u32x4 vv = {ktp[4 * i], ktp[4 * i + 1], ktp[4 * i + 2], ktp[4 * i + 3]}; dst[i] = vv; }
        }
        if (half == 0) DEC[item * 256 + kcol] = __expf(last);
        __syncthreads();
        const int ttile = wid >> 1;
#pragma unroll
        for (int i = 0; i < 2; ++i) {
            const int st = (wid & 1) * 2 + i; f32x4 acc = {0.f, 0.f, 0.f, 0.f};
#pragma unroll
            for (int kb = 0; kb < 8; ++kb) {
                const bf16x8 a = *(const LAS bf16x8*)(sK + (st * 16 + fr) * 264 + kb * 32 + fq * 8);
                const bf16x8 bq = *(const LAS bf16x8*)(sQ + (ttile * 16 + fr) * 264 + kb * 32 + fq * 8);
                acc = __builtin_amdgcn_mfma_f32_16x16x32_bf16(a, bq, acc, 0, 0, 0);
            }
            const int t = ttile * 16 + fr, s0 = st * 16 + 4 * fq;
            const float v0 = (s0 + 0 <= t) ? acc[0] : 0.f, v1 = (s0 + 1 <= t) ? acc[1] : 0.f, v2 = (s0 + 2 <= t) ? acc[2] : 0.f, v3 = (s0 + 3 <= t) ? acc[3] : 0.f;
            u32x2 pk = {pack2(v0, v1), pack2(v2, v3)};
            *(u32x2*)(PSC + (((size_t)item * 2 + (s0 >> 5)) * 64 + t) * 32 + (s0 & 31)) = pk;
        }
        __syncthreads();
    }
}

__device__ __forceinline__ void gla_scan(const P& p, LAS unsigned char* lds, const int mode = 3) {
    unsigned char* ws = p.ws;
    const bf16_t* PROJ = (const bf16_t*)(ws + OFF_R1);
    const bf16_t* QD = (const bf16_t*)(ws + OFF_QD); const bf16_t* KTE = (const bf16_t*)(ws + OFF_KTE); const bf16_t* PSC = (const bf16_t*)(ws + OFF_PSC); const float* DEC = (const float*)(ws + OFF_DEC);
    float* OGLA = (float*)(ws + OFF_OGLA);
    LAS bf16_t* sVT = (LAS bf16_t*)lds;
    LAS bf16_t* sST = sVT + 32 * 72;
    LAS bf16_t* sT = (LAS bf16_t*)(lds + 24576);
    const int tid = threadIdx.x, lane = tid & 63, wid = __builtin_amdgcn_readfirstlane(tid >> 6), fr = lane & 15, fq = lane >> 4;
    const int n4 = tid & 15, kr = tid >> 4;
    const int bid = blockIdx.x; const bool split = (gridDim.x % 16 == 0);
    const int role = split ? ((bid >> 3) & 1) : 0; const int ridx = split ? (((bid >> 4) << 3) | (bid & 7)) : bid; const int nrole = split ? (int)gridDim.x / 2 : (int)gridDim.x;
    if (role == 0 && (mode & 1)) {
    const int sw = wid & 3;
    const int item0 = (gridDim.x == 256) ? ((bid & 7) * 16 + (bid >> 4)) : ridx;
    for (int item = item0; item < 128; item += nrole) {
        const int vs = item & 15, bh = item >> 4; const int h = bh & 3, b = bh >> 2;
        for (int i = tid; i < 32 * 264 / 2; i += 512) ((LAS unsigned*)sST)[i] = 0u;
        f32x4 S[2][4];
#pragma unroll
        for (int v = 0; v < 2; ++v)
#pragma unroll
            for (int i = 0; i < 4; ++i) S[v][i] = (f32x4){0.f, 0.f, 0.f, 0.f};
        u32x4 vrA = {0u, 0u, 0u, 0u}, vrB = {0u, 0u, 0u, 0u}; bf16x8 xfA[10], xfB[10]; float dA[4], dB[4];
#pragma unroll
        for (int k = 0; k < 10; ++k) { xfA[k] = (bf16x8){0, 0, 0, 0, 0, 0, 0, 0}; xfB[k] = xfA[k]; }
#pragma unroll
        for (int k = 0; k < 4; ++k) { dA[k] = 0.f; dB[k] = 0.f; }
#define GLA_LOAD(nn, VR, XF, DD) do { const int _tok0 = b * SEQ + (nn) * 64; const size_t _bhn = (size_t)bh * 64 + (nn); \
        if (tid < 256) VR = __builtin_nontemporal_load((const u32x4*)(PROJ + (size_t)(_tok0 + (tid >> 2)) * 6144 + 2048 + h * 512 + vs * 32 + (tid & 3) * 8)); \
        if (wid < 4) { \
            _Pragma("unroll") for (int _k = 0; _k < 8; ++_k) XF[_k] = *(const bf16x8*)(QD + ((_bhn * 8 + _k) * 64 + 16 * sw + fr) * 32 + fq * 8); \
            _Pragma("unroll") for (int _s = 0; _s < 2; ++_s) XF[8 + _s] = *(const bf16x8*)(PSC + ((_bhn * 2 + _s) * 64 + 16 * sw + fr) * 32 + fq * 8); \
        } else { \
            _Pragma("unroll") for (int _i = 0; _i < 4; ++_i) { _Pragma("unroll") for (int _t = 0; _t < 2; ++_t) XF[_i * 2 + _t] = *(const bf16x8*)(KTE + (_bhn * 256 + (4 * sw + _i) * 16 + fr) * 64 + _t * 32 + fq * 8); \
                DD[_i] = DEC[_bhn * 256 + (4 * sw + _i) * 16 + fr]; } } } while (0)
#define GLA_STEP(nn, VR, XF, DD, NEXTLOAD) do { \
        if (tid < 256) { const int _t = tid >> 2, _hv = tid & 3; \
            _Pragma("unroll") for (int _j = 0; _j < 4; ++_j) { sVT[(_hv * 8 + 2 * _j) * 72 + _t] = (bf16_t)(VR[_j] & 0xFFFFu); sVT[(_hv * 8 + 2 * _j + 1) * 72 + _t] = (bf16_t)(VR[_j] >> 16); } } \
        NEXTLOAD; \
        LDS_BARRIER(); \
        if (wid < 4) { \
            f32x4 _c00 = {0.f, 0.f, 0.f, 0.f}, _c01 = _c00, _c10 = _c00, _c11 = _c00;     \
            _Pragma("unroll") for (int _sb = 0; _sb < 2; ++_sb) { const bf16x8 _x0 = *(const LAS bf16x8*)(sVT + fr * 72 + _sb * 32 + fq * 8); const bf16x8 _x1 = *(const LAS bf16x8*)(sVT + (16 + fr) * 72 + _sb * 32 + fq * 8); \
                if (_sb) { _c01 = __builtin_amdgcn_mfma_f32_16x16x32_bf16(_x0, XF[8 + _sb], _c01, 0, 0, 0); _c11 = __builtin_amdgcn_mfma_f32_16x16x32_bf16(_x1, XF[8 + _sb], _c11, 0, 0, 0); } \
                else { _c00 = __builtin_amdgcn_mfma_f32_16x16x32_bf16(_x0, XF[8 + _sb], _c00, 0, 0, 0); _c10 = __builtin_amdgcn_mfma_f32_16x16x32_bf16(_x1, XF[8 + _sb], _c10, 0, 0, 0); } } \
            _Pragma("unroll") for (int _kb = 0; _kb < 8; ++_kb) { const bf16x8 _x0 = *(const LAS bf16x8*)(sST + fr * 264 + _kb * 32 + fq * 8); const bf16x8 _x1 = *(const LAS bf16x8*)(sST + (16 + fr) * 264 + _kb * 32 + fq * 8); \
                if (_kb & 1) { _c01 = __builtin_amdgcn_mfma_f32_16x16x32_bf16(_x0, XF[_kb], _c01, 0, 0, 0); _c11 = __builtin_amdgcn_mfma_f32_16x16x32_bf16(_x1, XF[_kb], _c11, 0, 0, 0); } \
                else { _c00 = __builtin_amdgcn_mfma_f32_16x16x32_bf16(_x0, XF[_kb], _c00, 0, 0, 0); _c10 = __builtin_amdgcn_mfma_f32_16x16x32_bf16(_x1, XF[_kb], _c10, 0, 0, 0); } } \
            *(f32x4*)(OGLA + (size_t)(b * SEQ + (nn) * 64 + 16 * sw + fr) * DM + h * 512 + vs * 32 + 4 * fq) = _c00 + _c01; \
            *(f32x4*)(OGLA + (size_t)(b * SEQ + (nn) * 64 + 16 * sw + fr) * DM + h * 512 + vs * 32 + 16 + 4 * fq) = _c10 + _c11; \
        } else { \
            _Pragma("unroll") for (int _i = 0; _i < 4; ++_i) { S[0][_i] *= DD[_i]; S[1][_i] *= DD[_i]; } \
            _Pragma("unroll") for (int _tb = 0; _tb < 2; ++_tb) { const bf16x8 _a = *(const LAS bf16x8*)(sVT + fr * 72 + _tb * 32 + fq * 8); const bf16x8 _b = *(const LAS bf16x8*)(sVT + (16 + fr) * 72 + _tb * 32 + fq * 8); \
                _Pragma("unroll") for (int _i = 0; _i < 4; ++_i) { S[0][_i] = __builtin_amdgcn_mfma_f32_16x16x32_bf16(_a, XF[_i * 2 + _tb], S[0][_i], 0, 0, 0); S[1][_i] = __builtin_amdgcn_mfma_f32_16x16x32_bf16(_b, XF[_i * 2 + _tb], S[1][_i], 0, 0, 0); } } } \
        LDS_BARRIER(); \
        if (wid >= 4) { _Pragma("unroll") for (int _v = 0; _v < 2; ++_v) _Pragma("unroll") for (int _i = 0; _i < 4; ++_i) _Pragma("unroll") for (int _j = 0; _j < 4; ++_j) \
            sST[(_v * 16 + 4 * fq + _j) * 264 + (4 * sw + _i) * 16 + fr] = f2bf(S[_v][_i][_j]); } } while (0)
        GLA_LOAD(0, vrA, xfA, dA);
        for (int n = 0; n < 64; n += 2) {
            GLA_STEP(n, vrA, xfA, dA, GLA_LOAD(n + 1, vrB, xfB, dB));
            GLA_STEP(n + 1, vrB, xfB, dB, if (n + 2 < 64) GLA_LOAD(n + 2, vrA, xfA, dA));
        }
#undef GLA_LOAD
#undef GLA_STEP
        LDS_BARRIER();
    }
    }
    if ((role == 1 || !split) && (mode & 2)) {
        int cg_next = ridx; f32x4 cv[4][4]; float cgn[4][4]; bool c_have[4]; bf16_t* c_dst[4]; int c_K[4];
#pragma unroll
        for (int u = 0; u < 4; ++u) { c_have[u] = false; c_dst[u] = nullptr; c_K[u] = 0;
#pragma unroll
            for (int q = 0; q < 4; ++q) { cv[u][q] = (f32x4){0.f, 0.f, 0.f, 0.f}; cgn[u][q] = 1.f; } }
#define CONV_ISSUE_ALL() do { const float* _W = nullptr; const float* _gp = nullptr; bf16_t* _Wt = nullptr; int _ldw = 0, _K = 0, _bt = 0; \
        const bool _hv = (cg_next < CONV_BATCHES) && conv_locate(p, cg_next, _W, _ldw, _K, _gp, _Wt, _bt); cg_next += nrole; \
        _Pragma("unroll") for (int _u = 0; _u < 4; ++_u) c_have[_u] = _hv; \
        if (_hv) { const int _nb4cnt = conv_nb2(p, _W) >> 1; const int _kb = _bt / _nb4cnt, _nb4 = _bt - _kb * _nb4cnt;     \
            _Pragma("unroll") for (int _u = 0; _u < 4; ++_u) { const int _n0 = (4 * _nb4 + _u) * 64, _k0 = _kb * 128; c_K[_u] = _K; c_dst[_u] = _Wt + (size_t)_n0 * _K + _k0; \
                _Pragma("unroll") for (int _q = 0; _q < 4; ++_q) { const int _k = _k0 + 4 * kr + _q; cv[_u][_q] = __builtin_nontemporal_load((const f32x4*)(_W + (size_t)_k * _ldw + _n0 + n4 * 4)); cgn[_u][_q] = _gp ? _gp[_k] : 1.f; } } } } while (0)
        CONV_ISSUE_ALL();
        while (c_have[0]) {
            bf16_t* cd[4]; int cK[4]; bool ch[4];
#pragma unroll
            for (int u = 0; u < 4; ++u) { cd[u] = c_dst[u]; cK[u] = c_K[u]; ch[u] = c_have[u];
                if (ch[u]) {
#pragma unroll
                    for (int j = 0; j < 4; ++j) {
                        u32x2 pk = {pack2(cv[u][0][j] * cgn[u][0], cv[u][1][j] * cgn[u][1]), pack2(cv[u][2][j] * cgn[u][2], cv[u][3][j] * cgn[u][3])};
                        *(LAS u32x2*)(sT + u * (64 * 132) + (n4 * 4 + j) * 132 + 4 * kr) = pk;
                    }
                } }
            CONV_ISSUE_ALL();
            LDS_BARRIER();
#pragma unroll
            for (int u = 0; u < 4; ++u) if (ch[u]) {
#pragma unroll
                for (int q = 0; q < 2; ++q) { const int c = tid + 512 * q; const int n = c >> 4, kc = c & 15; const u32x2 d0 = *(const LAS u32x2*)(sT + u * (64 * 132) + n * 132 + kc * 8), d1 = *(const LAS u32x2*)(sT + u * (64 * 132) + n * 132 + kc * 8 + 4); const u32x4 dd = {d0[0], d0[1], d1[0], d1[1]}; __builtin_nontemporal_store(dd, (u32x4*)(cd[u] + (size_t)n * cK[u] + kc * 8)); }
            }
            LDS_BARRIER();
        }
#undef CONV_ISSUE_ALL
    }
}

__device__ __forceinline__ void gla_gate(const P& p) {
    unsigned char* ws = p.ws;
    const bf16_t* PROJ = (const bf16_t*)(ws + OFF_R1); const float* OGLA = (const float*)(ws + OFF_OGLA); bf16_t* OG = (bf16_t*)(ws + OFF_OG);
    const int lane = threadIdx.x & 63, wave = threadIdx.x >> 6;
    float hn[8];
#pragma unroll
    for (int j = 0; j < 8; ++j) hn[j] = p.gla_head_norm[lane * 8 + j];
    f32x4 no0 = {0.f, 0.f, 0.f, 0.f}, no1 = no0; u32x4 nrr = {0u, 0u, 0u, 0u};
#define GATE_LOAD(task_) do { const int _tok = (task_) >> 2, _h = (task_) & 3; const float* _op = OGLA + (size_t)_tok * DM + _h * 512 + lane * 8; \
        no0 = __builtin_nontemporal_load((const f32x4*)_op); no1 = __builtin_nontemporal_load((const f32x4*)(_op + 4)); nrr = __builtin_nontemporal_load((const u32x4*)(PROJ + (size_t)_tok * 6144 + 4096 + _h * 512 + lane * 8)); } while (0)
    const int task0 = blockIdx.x * 8 + wave, tstep = gridDim.x * 8;
    if (task0 < NTOK * 4) GATE_LOAD(task0);
    for (int task = task0; task < NTOK * 4; task += tstep) {
        const int tok = task >> 2, h = task & 3;
        const f32x4 o0 = no0, o1 = no1; const u32x4 rr = nrr;
        if (task + tstep < NTOK * 4) GATE_LOAD(task + tstep);
        float ss = o0[0] * o0[0] + o0[1] * o0[1] + o0[2] * o0[2] + o0[3] * o0[3] + o1[0] * o1[0] + o1[1] * o1[1] + o1[2] * o1[2] + o1[3] * o1[3];
        ss = wave_sum(ss);
        const float rs = rsqrtf(ss * (1.f / 512.f) + 1e-6f);
        float o[8] = {o0[0], o0[1], o0[2], o0[3], o1[0], o1[1], o1[2], o1[3]};
        float r[8] = {bflo(rr[0]), bfhi(rr[0]), bflo(rr[1]), bfhi(rr[1]), bflo(rr[2]), bfhi(rr[2]), bflo(rr[3]), bfhi(rr[3])};
        float y[8];
#pragma unroll
        for (int j = 0; j < 8; ++j) { const float sg = __fdividef(r[j], 1.f + __expf(-r[j])); y[j] = o[j] * rs * hn[j] * sg; }
        u32x4 pk = {pack2(y[0], y[1]), pack2(y[2], y[3]), pack2(y[4], y[5]), pack2(y[6], y[7])};
        *(u32x4*)(OG + (size_t)tok * DM + h * 512 + lane * 8) = pk;
    }
#undef GATE_LOAD
}

__device__ __forceinline__ float gelu_erf(float v) {
    const float av = fabsf(v), dd = av * 0.2316418882f + 1.0f;
    const float t = __builtin_amdgcn_rcpf(dd);
    float q = t * 0.5307027145f + (-0.7265760135f); q = q * t + 0.7107068705f; q = q * t + (-0.142248368f); q = q * t + 0.127414796f; q = q * t;
    const float e = __builtin_amdgcn_exp2f(v * v * (-0.72134752044f));
    const float mm = v * (q * e), rr = v - mm;
    return v < 0.f ? mm : rr;
}

__device__ __forceinline__ void convglu(const bf16_t* __restrict__ UG, bf16_t* __restrict__ ACT, const float* __restrict__ cw, const float* __restrict__ cb) {
    const int gtid = blockIdx.x * 512 + threadIdx.x, nth = gridDim.x * 512;
    for (int T = gtid; T < 512 * 704; T += nth) {
        const int run = T / 704, cgi = T - run * 704; const int c0 = cgi * 8, t0 = run * 16;
        float w0[8], w1[8], w2[8], bb[8], gm2[8], gm1[8];
#pragma unroll
        for (int j = 0; j < 8; ++j) { w0[j] = cw[c0 + j]; w1[j] = cw[DFF + c0 + j]; w2[j] = cw[2 * DFF + c0 + j]; bb[j] = cb[c0 + j]; gm2[j] = 0.f; gm1[j] = 0.f; }
        if ((t0 & (SEQ - 1)) != 0) {
            const u32x4 a = *(const u32x4*)(UG + (size_t)(t0 - 2) * (2 * DFF) + DFF + c0), c = *(const u32x4*)(UG + (size_t)(t0 - 1) * (2 * DFF) + DFF + c0);
#pragma unroll
            for (int j = 0; j < 4; ++j) { gm2[2 * j] = bflo(a[j]); gm2[2 * j + 1] = bfhi(a[j]); gm1[2 * j] = bflo(c[j]); gm1[2 * j + 1] = bfhi(c[j]); }
        }
#pragma unroll 4
        for (int tt = 0; tt < 16; ++tt) {
            const size_t tok = (size_t)(t0 + tt);
            const u32x4 gu = __builtin_nontemporal_load((const u32x4*)(UG + tok * (2 * DFF) + DFF + c0)), uu = __builtin_nontemporal_load((const u32x4*)(UG + tok * (2 * DFF) + c0));
            float gv[8], uv[8], y[8];
#pragma unroll
            for (int j = 0; j < 4; ++j) { gv[2 * j] = bflo(gu[j]); gv[2 * j + 1] = bfhi(gu[j]); uv[2 * j] = bflo(uu[j]); uv[2 * j + 1] = bfhi(uu[j]); }
#pragma unroll
            for (int j = 0; j < 8; ++j) { const float xv = w0[j] * gm2[j] + w1[j] * gm1[j] + w2[j] * gv[j] + bb[j]; y[j] = gelu_erf(xv) * uv[j]; gm2[j] = gm1[j]; gm1[j] = gv[j]; }
            u32x4 pk = {pack2(y[0], y[1]), pack2(y[2], y[3]), pack2(y[4], y[5]), pack2(y[6], y[7])};
            *(u32x4*)(ACT + tok * DFF + c0) = pk;
        }
    }
}

__device__ __forceinline__ void attn_phase(const P& p, LAS unsigned char* lds) {
    unsigned char* ws = p.ws;
    const bf16_t* KVQ = (const bf16_t*)(ws + OFF_R1); bf16_t* ATTO = (bf16_t*)(ws + OFF_ATTO); float* LSE = (float*)(ws + OFF_LSE);
    LAS bf16_t* sK = (LAS bf16_t*)lds;
    LAS bf16_t* sV = sK + 256 * 136;
    const int tid = threadIdx.x, lane = tid & 63, wid = __builtin_amdgcn_readfirstlane(tid >> 6), fr = lane & 15, fq = lane >> 4;
    const int ch = tid & 15, r0 = tid >> 4;
    u32x4 kk[8], vv[8]; bf16x8 qn[4];
#define ATT_DECODE(it, G, B_, H_, DL, QB, TB) const int G = (it) >> 10, B_ = ((it) >> 9) & 1, H_ = ((it) >> 5) & 15, DL = 2 * G; const int QB = ((it) & 31) & ((32 >> DL) - 1); const int TB = B_ * SEQ + (((it) & 31) >> (5 - DL));
#define ATT_LOADK(it) do { ATT_DECODE(it, _g, _b, _h, _dl, _qb, _tb) \
        _Pragma("unroll") for (int _ps = 0; _ps < 8; ++_ps) { const int _ik = (_qb - 1) * 128 + _ps * 32 + r0; \
            if (_ik >= 0) kk[_ps] = *(const u32x4*)(KVQ + (size_t)(_tb + (_ik << _dl)) * 10240 + _h * 128 + ch * 8); else kk[_ps] = (u32x4){0u, 0u, 0u, 0u}; } \
        { const bf16_t* _qs = KVQ + (size_t)(_tb + ((_qb * 128 + 16 * wid + fr) << _dl)) * 10240 + 4096 + _g * 2048 + _h * 128; \
          _Pragma("unroll") for (int _eb = 0; _eb < 4; ++_eb) qn[_eb] = __builtin_nontemporal_load((const bf16x8*)(_qs + _eb * 32 + fq * 8)); } } while (0)
#define ATT_LOADV(it) do { ATT_DECODE(it, _g, _b, _h, _dl, _qb, _tb) \
        _Pragma("unroll") for (int _ps = 0; _ps < 8; ++_ps) { const int _ik = (_qb - 1) * 128 + _ps * 32 + r0; \
            if (_ik >= 0) vv[_ps] = *(const u32x4*)(KVQ + (size_t)(_tb + (_ik << _dl)) * 10240 + 2048 + _h * 128 + ch * 8); else vv[_ps] = (u32x4){0u, 0u, 0u, 0u}; } } while (0)
    const bool xmap = (gridDim.x == 256); const int xcd = (int)blockIdx.x & 7, cu = (int)blockIdx.x >> 3;
    const int nsteps = xmap ? 12 : (((int)blockIdx.x < 3072) ? (3072 - 1 - (int)blockIdx.x) / (int)gridDim.x + 1 : 0);
#define ATT_ITEM(s) (xmap ? ((((((s) % 3) * 2 + ((xcd * 4 + (s) / 3) >> 4)) * 16 + ((xcd * 4 + (s) / 3) & 15)) * 32) + cu) : ((int)blockIdx.x + (s) * (int)gridDim.x))
    if (nsteps > 0) { const int it0 = ATT_ITEM(0); ATT_LOADK(it0); }
    for (int st = 0; st < nsteps; ++st) {
        const int item = ATT_ITEM(st); const int item_next = (st + 1 < nsteps) ? ATT_ITEM(st + 1) : -1;
        ATT_DECODE(item, g, b, h, dl, qb, tokbase)
#pragma unroll
        for (int ps = 0; ps < 8; ++ps) *(LAS u32x4*)(sK + (ps * 32 + r0) * 136 + ch * 8) = kk[ps];
        bf16x8 qf[4];
#pragma unroll
        for (int eb = 0; eb < 4; ++eb) qf[eb] = qn[eb];
        ATT_LOADV(item);
        LDS_BARRIER();
        const int iq = qb * 128 + 16 * wid + fr; const int tokq = tokbase + (iq << dl);
        f32x4 sc[9];
#pragma unroll
        for (int i = 0; i < 9; ++i) {
            f32x4 acc = {0.f, 0.f, 0.f, 0.f};
#pragma unroll
            for (int eb = 0; eb < 4; ++eb) { const bf16x8 a = *(const LAS bf16x8*)(sK + ((wid + i) * 16 + fr) * 136 + eb * 32 + fq * 8); acc = __builtin_amdgcn_mfma_f32_16x16x32_bf16(a, qf[eb], acc, 0, 0, 0); }
            sc[i] = acc;
        }
        const float c1 = 0.08838834764831845f * 1.4426950408889634f;
        const float slope2 = exp2f(-0.5f * (float)(h + 1)) * 1.4426950408889634f * (float)(1 << dl);
        float mx = -INFINITY;
        const int dlt = fr - 4 * fq; const float b0 = -slope2 * (float)(128 + dlt);
#pragma unroll
        for (int i = 0; i < 9; ++i) {
            const bool tile_ok = (qb > 0) || (wid + i >= 8);
#pragma unroll
            for (int j = 0; j < 4; ++j) {
                bool valid = tile_ok;
                if (i == 0) valid = valid && (dlt - j <= 0);
                if (i == 8) valid = valid && (dlt - j >= 0);
                const float sv = fmaf(sc[i][j], c1, b0 + slope2 * (float)(16 * i + j));
                const float s = valid ? sv : -INFINITY; sc[i][j] = s; mx = fmaxf(mx, s);
            }
        }
        mx = fmaxf(mx, __shfl_xor(mx, 16)); mx = fmaxf(mx, __shfl_xor(mx, 32));
        float lsum = 0.f;
#pragma unroll
        for (int i = 0; i < 9; ++i)
#pragma unroll
            for (int j = 0; j < 4; ++j) { const float pv = exp2f(sc[i][j] - mx); sc[i][j] = pv; lsum += pv; }
        lsum += __shfl_xor(lsum, 16); lsum += __shfl_xor(lsum, 32);
#pragma unroll
        for (int ps = 0; ps < 8; ++ps) *(LAS u32x4*)(sV + (ps * 32 + r0) * 144 + ch * 8) = vv[ps];
        if (item_next >= 0) ATT_LOADK(item_next);
        LDS_BARRIER();
        f32x4 O[8];
#pragma unroll
        for (int et = 0; et < 8; ++et) O[et] = (f32x4){0.f, 0.f, 0.f, 0.f};
        const int q4 = (lane & 15) >> 2, p4 = lane & 3;
#pragma unroll
        for (int pr = 0; pr < 5; ++pr) {
            const int i0 = 2 * pr, i1 = (2 * pr + 1 < 9) ? 2 * pr + 1 : 2 * pr;
            u32x4 pbu;
            pbu[0] = pack2(sc[i0][0], sc[i0][1]); pbu[1] = pack2(sc[i0][2], sc[i0][3]);
            if (2 * pr + 1 < 9) { pbu[2] = pack2(sc[i1][0], sc[i1][1]); pbu[3] = pack2(sc[i1][2], sc[i1][3]); } else { pbu[2] = 0u; pbu[3] = 0u; }
            bf16x8 pb; { union { u32x4 u; bf16x8 s; } cv; cv.u = pbu; pb = cv.s; }
            const int row0 = (wid + i0) * 16 + 4 * fq + q4, row1 = (wid + i1) * 16 + 4 * fq + q4;
#pragma unroll
            for (int et = 0; et < 8; ++et) {
                const s16x4 lo = __builtin_amdgcn_ds_read_tr16_b64_v4i16((LAS s16x4*)(sV + row0 * 144 + et * 16 + 4 * p4));
                const s16x4 hi = __builtin_amdgcn_ds_read_tr16_b64_v4i16((LAS s16x4*)(sV + row1 * 144 + et * 16 + 4 * p4));
                const bf16x8 a = {lo[0], lo[1], lo[2], lo[3], hi[0], hi[1], hi[2], hi[3]};
                O[et] = __builtin_amdgcn_mfma_f32_16x16x32_bf16(a, pb, O[et], 0, 0, 0);
            }
        }
        const float inv = 1.f / lsum;
        bf16_t* od = ATTO + ((size_t)g * NTOK + tokq) * DM + h * 128 + 4 * fq;
#pragma unroll
        for (int et = 0; et < 8; ++et) { u32x2 pk = {pack2(O[et][0] * inv, O[et][1] * inv), pack2(O[et][2] * inv, O[et][3] * inv)}; *(u32x2*)(od + et * 16) = pk; }
        if (fq == 0) LSE[((size_t)g * NTOK + tokq) * 16 + h] = (mx + log2f(lsum)) * 0.6931471805599453f;
    }
    LDS_BARRIER();
#undef ATT_ITEM
#undef ATT_LOADK
#undef ATT_LOADV
#undef ATT_DECODE
}

__device__ __forceinline__ void attn_merge(const P& p) {
    unsigned char* ws = p.ws;
    const bf16_t* ATTO = (const bf16_t*)(ws + OFF_ATTO); const float* LSE = (const float*)(ws + OFF_LSE); bf16_t* OG = (bf16_t*)(ws + OFF_OG);
    const int gtid = blockIdx.x * 512 + threadIdx.x, nth = gridDim.x * 512;
    float nl0 = 0.f, nl1 = 0.f, nl2 = 0.f; u32x4 na = {0u, 0u, 0u, 0u}, nb = na, nc = na;
#define MERGE_LOAD(T_) do { const int _tok = (T_) >> 8, _ch = (T_) & 255, _h = _ch >> 4; \
        nl0 = LSE[(size_t)_tok * 16 + _h]; nl1 = LSE[((size_t)NTOK + _tok) * 16 + _h]; nl2 = LSE[((size_t)2 * NTOK + _tok) * 16 + _h]; \
        na = __builtin_nontemporal_load((const u32x4*)(ATTO + (size_t)_tok * DM + _ch * 8)); nb = __builtin_nontemporal_load((const u32x4*)(ATTO + ((size_t)NTOK + _tok) * DM + _ch * 8)); nc = __builtin_nontemporal_load((const u32x4*)(ATTO + ((size_t)2 * NTOK + _tok) * DM + _ch * 8)); } while (0)
    if (gtid < NTOK * 256) MERGE_LOAD(gtid);
    for (int T = gtid; T < NTOK * 256; T += nth) {
        const int tok = T >> 8, ch = T & 255;
        const float l0 = nl0, l1 = nl1, l2 = nl2; const u32x4 a = na, bq = nb, c = nc;
        if (T + nth < NTOK * 256) MERGE_LOAD(T + nth);
        const float m = fmaxf(l0, fmaxf(l1, l2)); float w0 = __expf(l0 - m), w1 = __expf(l1 - m), w2 = __expf(l2 - m); const float inv = __fdividef(1.f, w0 + w1 + w2); w0 *= inv; w1 *= inv; w2 *= inv;
        u32x4 pk;
#pragma unroll
        for (int j = 0; j < 4; ++j) pk[j] = pack2(w0 * bflo(a[j]) + w1 * bflo(bq[j]) + w2 * bflo(c[j]), w0 * bfhi(a[j]) + w1 * bfhi(bq[j]) + w2 * bfhi(c[j]));
        *(u32x4*)(OG + (size_t)tok * DM + ch * 8) = pk;
    }
#undef MERGE_LOAD
}

constexpr int N_PHASES = 17;
__device__ __forceinline__ void run_gemm_scale(const P& p, LAS unsigned char* lds, size_t offA, size_t offB, int N, int K, bf16_t* O, int ldo, const float* rstd, int nvalid, float* aout) {
    pg8::Gemm g{(const bf16_t*)(p.ws + offA), (const bf16_t*)(p.ws + offB), NTOK, N, K};
    pg8::StaticOrder S; S.init(NTOK, N, gridDim.x, blockIdx.x);
    EpiScaleBf16 E{O, ldo, rstd, nvalid, aout};
    pg8::gemm_phase<EpiScaleBf16, pg8::StaticOrder, true, true>(lds, g, S, E);
}
template <bool BASE_BF16> __device__ __forceinline__ void run_gemm_resid(const P& p, LAS unsigned char* lds, size_t offA, size_t offB, int K, const void* base, float* out) {
    pg8::Gemm g{(const bf16_t*)(p.ws + offA), (const bf16_t*)(p.ws + offB), NTOK, DM, K};
    pg8::StaticOrder S; S.init(NTOK, DM, gridDim.x, blockIdx.x);
    EpiResid<BASE_BF16> E{base, out};
    pg8::gemm_phase<EpiResid<BASE_BF16>, pg8::StaticOrder, true, true>(lds, g, S, E);
}
template <bool BASE_BF16> __device__ __forceinline__ void run_gemm_resid_norm(const P& p, LAS unsigned char* lds, size_t offA, size_t offB, int K, const void* base, float* sumsq) {
    pg8::Gemm g{(const bf16_t*)(p.ws + offA), (const bf16_t*)(p.ws + offB), NTOK, DM, K};
    pg8::StaticOrder S; S.init(NTOK, DM, gridDim.x, blockIdx.x);
    EpiResidNorm<BASE_BF16> E{base, (bf16_t*)(p.ws + OFF_XB), sumsq};
    pg8::gemm_phase<EpiResidNorm<BASE_BF16>, pg8::StaticOrder, true, true>(lds, g, S, E);
}
__global__ void __launch_bounds__(512, 2) mk_fwd(P p) {
    extern __shared__ __attribute__((aligned(16))) unsigned char lds_raw[];
    LAS unsigned char* lds = (LAS unsigned char*)lds_raw;
    unsigned char* ws = p.ws;
    float* RSTD = (float*)(ws + OFF_RSTD);
    float* H = p.out;
#ifndef PHMASK
#define PHMASK 0xFFFFF
#endif
    const int lo = p.ph_lo, hi = p.ph_hi;
    volatile LAS unsigned* xst = (volatile LAS unsigned*)(lds + LDS_BYTES - 16);
    if (threadIdx.x < 4) xst[threadIdx.x] = 0u;
    __syncthreads();
    XcdBarrier xb; xb.bar = (unsigned*)(ws + OFF_BAR); xb.x = 0; xb.st = xst;
    if (hi - lo > 1) xb = xcd_barrier_post((unsigned*)(ws + OFF_BAR), xst);
#define GRID_SEAM(k) do { if (p.ph_hi > 1000) { __syncthreads(); cg::this_grid().sync(); } xcd_barrier(xb); } while (0)
#ifndef PHDUP
#define PHDUP 0x0
#endif
#define PHASE(k, body) if (((PHMASK >> (k)) & 1) && lo <= (k) && (k) < hi) { if ((PHDUP >> (k)) & 1) { body; xcd_barrier(xb); } body; if ((k) + 1 < hi) GRID_SEAM(k); }
#ifdef PROBE_SYNCS
    if (hi - lo > 1) { for (int i = 0; i < PROBE_SYNCS; ++i) xcd_barrier(xb); }
#endif
    PHASE(0, phase_prologue(p, lds))
    PHASE(1, run_gemm_scale(p, lds, OFF_XB, OFF_WT_IN, 6144, DM, (bf16_t*)(ws + OFF_R1), 6144, RSTD, 6144, nullptr))
    PHASE(2, gla_prep(p, lds))
#ifdef PROBE_SCANMODE
    if (hi - lo > 1) { gla_scan(p, lds, PROBE_SCANMODE); xcd_barrier(xb); }
#endif
    PHASE(3, gla_scan(p, lds))
    PHASE(4, gla_gate(p))
    PHASE(5, run_gemm_resid_norm<false>(p, lds, OFF_OG, OFF_WT_GOUT, DM, p.x, RSTD + NTOK))
#ifdef PROBE_NULLGEMM
    if (hi - lo > 1) { pg8::Gemm g{(const bf16_t*)(p.ws + OFF_XB), (const bf16_t*)(p.ws + OFF_WT_UP0), NTOK, 2 * DFF, DM}; pg8::StaticOrder S; S.init(NTOK, 2 * DFF, gridDim.x, blockIdx.x); EpiNull E{(float*)(ws + OFF_AG)}; pg8::gemm_phase<EpiNull, pg8::StaticOrder, true, true>(lds, g, S, E); xcd_barrier(xb); }
#endif
    PHASE(6, run_gemm_scale(p, lds, OFF_XB, OFF_WT_UP0, 2 * DFF, DM, (bf16_t*)(ws + OFF_R1), 2 * DFF, RSTD + NTOK, 2 * DFF, nullptr))
    PHASE(7, convglu((const bf16_t*)(ws + OFF_R1), (bf16_t*)(ws + OFF_ACT), p.ffn_conv_w, p.ffn_conv_b))
    PHASE(8, run_gemm_resid_norm<true>(p, lds, OFF_ACT, OFF_WT_DN0, DFF, ws + OFF_XB, RSTD + 2 * NTOK))
    PHASE(9, run_gemm_scale(p, lds, OFF_XB, OFF_WT_KVQ, 10240, DM, (bf16_t*)(ws + OFF_R1), 10240, RSTD + 2 * NTOK, 10240, nullptr))
    PHASE(10, attn_phase(p, lds))
    PHASE(11, attn_merge(p))
    PHASE(12, run_gemm_resid_norm<true>(p, lds, OFF_OG, OFF_WT_AOUT, DM, ws + OFF_XB, RSTD + 3 * NTOK))
    PHASE(13, run_gemm_scale(p, lds, OFF_XB, OFF_WT_UP1, 2 * DFF, DM, (bf16_t*)(ws + OFF_R1), 2 * DFF, RSTD + 3 * NTOK, 2 * DFF, nullptr))
    PHASE(14, convglu((const bf16_t*)(ws + OFF_R1), (bf16_t*)(ws + OFF_ACT), p.ffn_conv_w + 3 * DFF, p.ffn_conv_b + DFF))
    PHASE(15, run_gemm_resid<true>(p, lds, OFF_ACT, OFF_WT_DN1, DFF, ws + OFF_XB, H))
    PHASE(16, final_norm_pass(H, p.final_norm))
}

extern "C" void kernel_launch(void* const* d_in, const int* in_sizes, int n_in, void* d_out, int out_size, void* d_ws, size_t ws_size, hipStream_t stream) {
    static int grid = 0;
    if (grid == 0) {
        if (n_in != 17 || out_size != NTOK * DM || ws_size < WS_END) { fprintf(stderr, "kernel_launch: unexpected shapes (n_in %d out %d ws %zu need %zu)\n", n_in, out_size, ws_size, (size_t)WS_END); grid = -1; return; }
        int dev = 0, cus = 0, per_cu = 0;
        hipGetDevice(&dev);
        hipDeviceGetAttribute(&cus, hipDeviceAttributeMultiprocessorCount, dev);
        if (hipFuncSetAttribute((const void*)mk_fwd, hipFuncAttributeMaxDynamicSharedMemorySize, LDS_BYTES) != hipSuccess) { fprintf(stderr, "kernel_launch: hipFuncSetAttribute failed\n"); grid = -1; return; }
        if (hipOccupancyMaxActiveBlocksPerMultiprocessor(&per_cu, (const void*)mk_fwd, 512, LDS_BYTES) != hipSuccess || per_cu < 1) { fprintf(stderr, "kernel_launch: occupancy query says %d\n", per_cu); per_cu = 1; }
        (void)hipGetLastError();
        grid = cus * 1;
        if (grid <= 0) grid = 256;
    }
    if (grid < 0) return;
    P p{};
    p.x = (const float*)d_in[0]; p.attn_norm = (const float*)d_in[1]; p.gla_w_in = (const float*)d_in[2]; p.gla_w_a2 = (const float*)d_in[3]; p.gla_b_a2 = (const float*)d_in[4];
    p.gla_head_norm = (const float*)d_in[5]; p.gla_w_out = (const float*)d_in[6]; p.kv_norm = (const float*)d_in[7]; p.w_kv = (const float*)d_in[8]; p.dsa_w_q = (const float*)d_in[9];
    p.dsa_w_out = (const float*)d_in[10]; p.ffn_norm = (const float*)d_in[11]; p.ffn_w_up = (const float*)d_in[12]; p.ffn_conv_w = (const float*)d_in[13]; p.ffn_conv_b = (const float*)d_in[14];
    p.ffn_w_down = (const float*)d_in[15]; p.final_norm = (const float*)d_in[16];
    p.out = (float*)d_out; p.ws = (unsigned char*)d_ws;
#if MK_ONE_LAUNCH
    if (hipMemsetAsync((char*)d_ws + OFF_BAR, 0, XCD_BAR_WORDS * 4, stream) != hipSuccess) { fprintf(stderr, "kernel_launch: memset of barrier words failed\n"); return; }
    p.ph_lo = 0; p.ph_hi = N_PHASES;
    void* args[] = {&p};
    hipError_t e = hipLaunchCooperativeKernel((const void*)mk_fwd, dim3(grid), dim3(512), args, LDS_BYTES, stream);
    if (e != hipSuccess) fprintf(stderr, "cooperative launch failed: %s (grid %d)\n", hipGetErrorString(e), grid);
#else
    for (int ph = 0; ph < N_PHASES; ++ph) {
        p.ph_lo = ph; p.ph_hi = ph + 1;
        hipLaunchKernelGGL(mk_fwd, dim3(grid), dim3(512), LDS_BYTES, stream, p);
    }
#endif
}
```

```cpp
#include <hip/hip_runtime.h>
#include <hip/hip_cooperative_groups.h>
#include <cstdio>
namespace cg = cooperative_groups;

#ifndef MK_ONE_LAUNCH
#define MK_ONE_LAUNCH 1
#endif

#define LAS __attribute__((address_space(3)))
typedef unsigned short bf16_t;
typedef short bf16x8 __attribute__((ext_vector_type(8)));
typedef short s16x4 __attribute__((ext_vector_type(4)));
typedef float f32x4 __attribute__((ext_vector_type(4)));
typedef unsigned u32x4 __attribute__((ext_vector_type(4)));
typedef unsigned u32x2 __attribute__((ext_vector_type(2)));

typedef __bf16 hwbf16x2 __attribute__((ext_vector_type(2)));
typedef float f32x2 __attribute__((ext_vector_type(2)));
__device__ __forceinline__ bf16_t f2bf(float f) { const __bf16 b = (__bf16)f; return __builtin_bit_cast(bf16_t, b); }
__device__ __forceinline__ float bf2f(bf16_t b) { return __uint_as_float(((unsigned)b) << 16); }
__device__ __forceinline__ unsigned pack2(float lo, float hi) { const f32x2 v = {lo, hi}; const hwbf16x2 b = __builtin_convertvector(v, hwbf16x2); return __builtin_bit_cast(unsigned, b); }
__device__ __forceinline__ float bflo(unsigned u) { return __uint_as_float(u << 16); }
__device__ __forceinline__ float bfhi(unsigned u) { return __uint_as_float(u & 0xFFFF0000u); }
#define LDS_BARRIER() do { asm volatile("s_waitcnt lgkmcnt(0)" ::: "memory"); __builtin_amdgcn_s_barrier(); asm volatile("" ::: "memory"); } while (0)
__device__ __forceinline__ float wave_sum(float v) {
#pragma unroll
    for (int o = 32; o > 0; o >>= 1) v += __shfl_xor(v, o);
    return v;
}

#define XB_TMO      128
#define XB_XCNT(j)  (256  + 64 * (j))
#define XB_XSUB(j)  (1280 + 64 * (j))
#define XB_XGEN(j)  (2304 + 64 * (j))
#define XB_TOP      3328
#define XB_TOPGEN   3392
#define XCD_BAR_WORDS 3456
#define XB_SPIN_CAP (1u << 18)
__device__ __forceinline__ unsigned xb_ld(unsigned* p)              { return __hip_atomic_load(p, __ATOMIC_RELAXED, __HIP_MEMORY_SCOPE_AGENT); }
__device__ __forceinline__ unsigned xb_add(unsigned* p, unsigned v) { return __hip_atomic_fetch_add(p, v, __ATOMIC_RELAXED, __HIP_MEMORY_SCOPE_AGENT); }
__device__ __forceinline__ unsigned xb_xcc_id() { return (unsigned)__builtin_amdgcn_s_getreg((3 << 11) | 20) & 0xFu; }
#define XB_SPIN(cond, bar) do { unsigned _sp = 0; while (cond) { __builtin_amdgcn_s_sleep(1); \
    if ((++_sp & 255u) == 0u) { if (xb_ld(&(bar)[XB_TMO])) break; if (_sp > XB_SPIN_CAP) { atomicAdd(&(bar)[XB_TMO], 1u); break; } } } } while (0)
struct XcdBarrier { unsigned* bar; unsigned x; volatile LAS unsigned* st; };
__device__ __forceinline__ XcdBarrier xcd_barrier_post(unsigned* bar, volatile LAS unsigned* st) {
    XcdBarrier b; b.bar = bar; b.x = xb_xcc_id(); b.st = st;
    if (threadIdx.x == 0) (void)xb_add(&bar[XB_XCNT(b.x)], 1u);
    return b;
}
__device__ __forceinline__ void xcd_barrier_complete(unsigned* bar, unsigned x, unsigned& nloc, unsigned& nx) {
    const unsigned G = gridDim.x * gridDim.y * gridDim.z;
    unsigned sum, cnt, mine, sp = 0u;
    for (;;) {
        sum = 0u; cnt = 0u; mine = 0u;
#pragma unroll
        for (unsigned j = 0; j < 16; ++j) { const unsigned c = xb_ld(&bar[XB_XCNT(j)]); sum += c; cnt += (c > 0u) ? 1u : 0u; mine = (j == x) ? c : mine; }
        if (sum == G) break;
        __builtin_amdgcn_s_sleep(1);
        if ((++sp & 255u) == 0u) { if (xb_ld(&bar[XB_TMO])) break; if (sp > XB_SPIN_CAP) { atomicAdd(&bar[XB_TMO], 1u); break; } }
    }
    nloc = mine > 0u ? mine : 1u; nx = cnt > 0u ? cnt : 1u;
}
__device__ __forceinline__ void xcd_barrier(const XcdBarrier& b) {
    asm volatile("s_waitcnt vmcnt(0)" ::: "memory");
    __syncthreads();
    if (threadIdx.x == 0) {
        unsigned* bar = b.bar;
        __builtin_amdgcn_s_waitcnt(0);
        unsigned nloc = b.st[0], nx = b.st[1];
        if (nloc == 0u) { xcd_barrier_complete(bar, b.x, nloc, nx); b.st[0] = nloc; b.st[1] = nx; }
        const unsigned old = xb_add(&bar[XB_XSUB(b.x)], 1u);
        const unsigned gen = old / nloc;
        if (old + 1u == (gen + 1u) * nloc) {
            __builtin_amdgcn_fence(__ATOMIC_RELEASE, "agent");
            asm volatile("s_waitcnt vmcnt(0)" ::: "memory");
            const unsigned og = xb_add(&bar[XB_TOP], 1u);
            const unsigned tg = og / nx;
            if (og + 1u == (tg + 1u) * nx) xb_add(&bar[XB_TOPGEN], 1u);
            else XB_SPIN(xb_ld(&bar[XB_TOPGEN]) == tg, bar);
            __builtin_amdgcn_fence(__ATOMIC_ACQUIRE, "agent");
            xb_add(&bar[XB_XGEN(b.x)], 1u);
            asm volatile("s_waitcnt vmcnt(0)" ::: "memory");
        } else {
            XB_SPIN(xb_ld(&bar[XB_XGEN(b.x)]) == gen, bar);
            __builtin_amdgcn_fence(__ATOMIC_ACQUIRE, "agent");
            asm volatile("s_waitcnt vmcnt(0)" ::: "memory");
        }
    }
    __syncthreads();
}

namespace pg8 {
constexpr int BM = 256, BK = 64, HALF = 128, HTB = HALF * BK * 2, STAGE_BYTES = 8 * HTB, NXCD = 8, WGM = 8;
__device__ __forceinline__ int lds_byte(int r, int c) { const int st = (r >> 4) * 2 + (c >> 5), rr = r & 15, cc = c & 31, ob = rr * 64 + cc * 2; return st * 1024 + (ob ^ (((ob >> 9) & 1) << 5)); }
__device__ __forceinline__ void stage_rc(int b, int& R, int& C) { const int st = b / 1024, sb = b % 1024, swz = sb ^ (((sb >> 9) & 1) << 5); R = (st >> 1) * 16 + swz / 64; C = (st & 1) * 32 + (swz % 64) / 2; }
__device__ __forceinline__ int perm32(int rho) { const int n = rho >> 4, i = rho & 15; return 8 * (i >> 2) + 4 * n + (i & 3); }
struct Unit { int pm, pn; };
struct Gemm { const bf16_t* A; const bf16_t* Bt; int M, N, K; };
struct StaticOrder {
    int nM, nN, nwg, G, c;
    __device__ void init(int M, int N, int G_, int c_) { nM = M / BM; nN = N / BM; nwg = nM * nN; G = G_; c = c_; }
    __device__ bool next(int i, Unit& u) const {
        const long L = (long)i * G + c; if (L >= nwg) return false;
        int wgid = (int)L; { const int q = nwg / NXCD, r = nwg % NXCD, xcd = wgid % NXCD, off = wgid / NXCD; wgid = (xcd < r ? xcd * (q + 1) : r * (q + 1) + (xcd - r) * q) + off; }
        const int nig = WGM * nN, gid = wgid / nig, fm = gid * WGM, gsz = (nM - fm) < WGM ? (nM - fm) : WGM;
        u.pm = fm + ((wgid % nig) % gsz); u.pn = (wgid % nig) / gsz; return true;
    }
    __device__ __forceinline__ void a_ready(const Unit&) const {}
    __device__ __forceinline__ void done(const Unit&) const {}
};

template <class Epi, class Sched, bool ALIGN_EPI = false, bool SP2 = false>
__device__ __forceinline__ void gemm_phase(LAS unsigned char* lds, const Gemm g, const Sched& S, const Epi& E) {
    const int tid = threadIdx.x, wid = __builtin_amdgcn_readfirstlane(tid >> 6), lane = tid & 63, wr = wid >> 2, wc = wid & 3, fr = lane & 15, fq = lane >> 4;
    const int K = g.K, nt = K / BK;
    unsigned voffA[2], voffB[2];
#pragma unroll
    for (int i = 0; i < 2; ++i) { int R, C; stage_rc(tid * 16 + i * 8192, R, C); const int Rb = Epi::PERM ? ((R & ~31) + perm32(R & 31)) : R;
        voffA[i] = (unsigned)(R * K + C) * 2u; voffB[i] = (unsigned)(Rb * K + C) * 2u; }
    const size_t kstep = (size_t)(BK * 2);
    const size_t hstep = (size_t)HALF * K * 2;
    const size_t tstep = 2 * hstep;
    const unsigned ldsw = (unsigned)wid * 1024u;
    const int aoff = lds_byte(wr * 64 + fr, fq * 8), boff = lds_byte(wc * 32 + fr, fq * 8);
#define PG8_SA(b, h) (((b) * 2 + (h)) * HTB)
#define PG8_SB(b, h) ((4 + (b) * 2 + (h)) * HTB)
#define PG8_STAGE(bufoff, gbase, voff) do { _Pragma("unroll") for (int _i = 0; _i < 2; ++_i) \
        __builtin_amdgcn_global_load_lds((const unsigned*)((const char*)(gbase) + (voff)[_i]), (LAS unsigned*)(lds + (bufoff) + ldsw + _i * 8192), 16, 0, 0); } while (0)
#define PG8_LDA(dst, b, h) do { _Pragma("unroll") for (int m = 0; m < 4; ++m) _Pragma("unroll") for (int k = 0; k < 2; ++k) dst[m][k] = *(const LAS bf16x8*)(lds + PG8_SA(b, h) + aoff + m * 2048 + k * 1024); } while (0)
#define PG8_LDB(dst, b, h) do { _Pragma("unroll") for (int n = 0; n < 2; ++n) _Pragma("unroll") for (int k = 0; k < 2; ++k) dst[n][k] = *(const LAS bf16x8*)(lds + PG8_SB(b, h) + boff + n * 2048 + k * 1024); } while (0)
#define PG8_MMA(ai, bj, At, Bt) do { __builtin_amdgcn_s_setprio(1); _Pragma("unroll") for (int m = 0; m < 4; ++m) _Pragma("unroll") for (int n = 0; n < 2; ++n) _Pragma("unroll") for (int k = 0; k < 2; ++k) \
        acc[ai][bj][m][n] = __builtin_amdgcn_mfma_f32_16x16x32_bf16(Bt[n][k], At[m][k], acc[ai][bj][m][n], 0, 0, 0); __builtin_amdgcn_s_setprio(0); } while (0)
#define PG8_WAIT_V(n) asm volatile("s_waitcnt vmcnt(" #n ")" ::: "memory")
#define PG8_WAIT_L(n) asm volatile("s_waitcnt lgkmcnt(" #n ")" ::: "memory")
#define PG8_BAR __builtin_amdgcn_s_barrier()
#define PG8_SCHED __builtin_amdgcn_sched_barrier(0)
    Unit cur, nxt; int ui = 0;
    if (!S.next(0, cur)) return;
    f32x4 acc[2][2][4][2];
#pragma unroll
    for (int a = 0; a < 2; ++a)
#pragma unroll
        for (int b = 0; b < 2; ++b)
#pragma unroll
            for (int m = 0; m < 4; ++m)
#pragma unroll
                for (int n = 0; n < 2; ++n) acc[a][b][m][n] = (f32x4){0.f, 0.f, 0.f, 0.f};
    bf16x8 At[4][2], B0[2][2], B1[2][2];
    const char* cA = (const char*)g.A + (size_t)cur.pm * tstep; const char* cB = (const char*)g.Bt + (size_t)cur.pn * tstep;
    S.a_ready(cur);
    if constexpr (SP2) {
        PG8_STAGE(PG8_SB(0, 0), cB, voffB); PG8_STAGE(PG8_SB(0, 1), cB + hstep, voffB); PG8_STAGE(PG8_SA(0, 0), cA, voffA); PG8_STAGE(PG8_SA(0, 1), cA + hstep, voffA);
        if (wr == 1) PG8_BAR;
        PG8_WAIT_V(2); PG8_BAR;
        PG8_STAGE(PG8_SB(1, 0), cB + kstep, voffB); PG8_STAGE(PG8_SA(1, 0), cA + kstep, voffA); PG8_STAGE(PG8_SB(1, 1), cB + hstep + kstep, voffB);
        PG8_WAIT_V(6); PG8_BAR;
    } else {
        PG8_STAGE(PG8_SB(0, 0), cB, voffB); PG8_STAGE(PG8_SA(0, 0), cA, voffA); PG8_STAGE(PG8_SB(0, 1), cB + hstep, voffB); PG8_STAGE(PG8_SA(0, 1), cA + hstep, voffA);
        if (wr == 1) PG8_BAR;
        PG8_WAIT_V(4); PG8_BAR;
        PG8_STAGE(PG8_SB(1, 0), cB + kstep, voffB); PG8_STAGE(PG8_SA(1, 0), cA + kstep, voffA); PG8_STAGE(PG8_SB(1, 1), cB + hstep + kstep, voffB);
        PG8_WAIT_V(6); PG8_BAR;
    }
    for (;;) {
        const bool has_next = S.next(ui + 1, nxt);
        const char* nA = has_next ? (const char*)g.A + (size_t)nxt.pm * tstep : cA; const char* nB = has_next ? (const char*)g.Bt + (size_t)nxt.pn * tstep : cB;
        for (int t = 0; t < nt; t += 2) {
            const bool last = (t == nt - 2);
            const char* a1 = cA + (size_t)(t + 1) * kstep;
            const char* a2 = last ? nA : cA + (size_t)(t + 2) * kstep; const char* b2 = last ? nB : cB + (size_t)(t + 2) * kstep;
            const char* a3 = a2 + kstep; const char* b3 = b2 + kstep;
            if (last && has_next) S.a_ready(nxt);
            if constexpr (SP2) {
            PG8_LDB(B0, 0, 0); PG8_LDB(B1, 0, 1); PG8_SCHED; PG8_LDA(At, 0, 0); PG8_STAGE(PG8_SA(1, 1), a1 + hstep, voffA);
            PG8_WAIT_V(8); PG8_WAIT_L(0); PG8_BAR; PG8_MMA(0, 0, At, B0); PG8_MMA(0, 1, At, B1); PG8_BAR; PG8_SCHED;
            PG8_LDA(At, 0, 1); PG8_STAGE(PG8_SB(0, 0), b2, voffB); PG8_STAGE(PG8_SB(0, 1), b2 + hstep, voffB); PG8_STAGE(PG8_SA(0, 0), a2, voffA);
            PG8_WAIT_V(8); PG8_WAIT_L(0); PG8_BAR; PG8_MMA(1, 0, At, B0); PG8_MMA(1, 1, At, B1); PG8_BAR; PG8_SCHED;
            PG8_LDB(B0, 1, 0); PG8_LDB(B1, 1, 1); PG8_SCHED; PG8_LDA(At, 1, 0); PG8_STAGE(PG8_SA(0, 1), a2 + hstep, voffA);
            PG8_WAIT_V(8); PG8_WAIT_L(0); PG8_BAR; PG8_MMA(0, 0, At, B0); PG8_MMA(0, 1, At, B1); PG8_BAR; PG8_SCHED;
            PG8_LDA(At, 1, 1); PG8_STAGE(PG8_SB(1, 0), b3, voffB); PG8_STAGE(PG8_SB(1, 1), b3 + hstep, voffB); PG8_STAGE(PG8_SA(1, 0), a3, voffA);
            PG8_WAIT_V(8); PG8_WAIT_L(0); PG8_BAR; PG8_MMA(1, 0, At, B0); PG8_MMA(1, 1, At, B1); PG8_BAR; PG8_SCHED;
            } else {
            PG8_LDB(B0, 0, 0); PG8_SCHED; PG8_LDA(At, 0, 0); PG8_STAGE(PG8_SA(1, 1), a1 + hstep, voffA);
            PG8_WAIT_L(8); PG8_BAR; PG8_WAIT_L(0); PG8_MMA(0, 0, At, B0); PG8_BAR; PG8_SCHED;
            PG8_LDB(B1, 0, 1); PG8_STAGE(PG8_SB(0, 0), b2, voffB);
            PG8_BAR; PG8_WAIT_L(0); PG8_MMA(0, 1, At, B1); PG8_BAR;
            PG8_LDA(At, 0, 1); PG8_STAGE(PG8_SA(0, 0), a2, voffA);
            PG8_BAR; PG8_WAIT_L(0); PG8_MMA(1, 0, At, B0); PG8_BAR; PG8_SCHED;
            PG8_STAGE(PG8_SB(0, 1), b2 + hstep, voffB);
            PG8_WAIT_V(6); PG8_BAR; PG8_MMA(1, 1, At, B1); PG8_BAR;
            PG8_LDB(B0, 1, 0); PG8_SCHED; PG8_LDA(At, 1, 0); PG8_STAGE(PG8_SA(0, 1), a2 + hstep, voffA);
            PG8_WAIT_L(8); PG8_BAR; PG8_WAIT_L(0); PG8_MMA(0, 0, At, B0); PG8_BAR; PG8_SCHED;
            PG8_LDB(B1, 1, 1); PG8_STAGE(PG8_SB(1, 0), b3, voffB);
            PG8_BAR; PG8_WAIT_L(0); PG8_MMA(0, 1, At, B1); PG8_BAR;
            PG8_LDA(At, 1, 1); PG8_STAGE(PG8_SA(1, 0), a3, voffA);
            PG8_BAR; PG8_WAIT_L(0); PG8_MMA(1, 0, At, B0); PG8_BAR; PG8_SCHED;
            PG8_STAGE(PG8_SB(1, 1), b3 + hstep, voffB);
            PG8_WAIT_V(6); PG8_BAR; PG8_MMA(1, 1, At, B1); PG8_BAR;
            }
        }
        if constexpr (ALIGN_EPI) { if (wr == 0) PG8_BAR; }
        if constexpr (!Epi::AFTER_DRAIN) { E(acc, cur, wr, wc, fr, fq); S.done(cur); }
        if (!has_next) break;
#pragma unroll
        for (int a = 0; a < 2; ++a)
#pragma unroll
            for (int b = 0; b < 2; ++b)
#pragma unroll
                for (int m = 0; m < 4; ++m)
#pragma unroll
                    for (int n = 0; n < 2; ++n) acc[a][b][m][n] = (f32x4){0.f, 0.f, 0.f, 0.f};
        cur = nxt; cA = nA; cB = nB; ++ui;
        if constexpr (ALIGN_EPI) { if (wr == 1) PG8_BAR; }
    }
    PG8_WAIT_V(0);
    if constexpr (!ALIGN_EPI) { if (wr == 0) PG8_BAR; }
    PG8_BAR;
    if constexpr (Epi::AFTER_DRAIN) { E.fused(acc, cur, wr, wc, fr, fq, lds, wid, lane); S.done(cur); }
#undef PG8_SA
#undef PG8_SB
#undef PG8_STAGE
#undef PG8_LDA
#undef PG8_LDB
#undef PG8_MMA
#undef PG8_WAIT_V
#undef PG8_WAIT_L
#undef PG8_BAR
#undef PG8_SCHED
}
}

struct EpiScaleBf16 {
    static constexpr bool PERM = true, AFTER_DRAIN = false;
    bf16_t* O; int ldo; const float* rstd; int nvalid; float* aout;
    __device__ __forceinline__ void operator()(const f32x4 (&acc)[2][2][4][2], const pg8::Unit& u, int wr, int wc, int fr, int fq) const {
        const int row0 = u.pm * 256 + wr * 64 + fr, colb = u.pn * 256 + wc * 32 + 8 * fq;
#pragma unroll
        for (int ai = 0; ai < 2; ++ai)
#pragma unroll
            for (int m = 0; m < 4; ++m) {
                const int r = row0 + ai * 128 + m * 16; const float s = rsqrtf(rstd[r] * (1.f / 2048.f) + 1e-6f);
#pragma unroll
                for (int bj = 0; bj < 2; ++bj) {
                    const int c = colb + bj * 128; const f32x4 v0 = acc[ai][bj][m][0] * s, v1 = acc[ai][bj][m][1] * s;
                    if (c < nvalid) { u32x4 pk = {pack2(v0[0], v0[1]), pack2(v0[2], v0[3]), pack2(v1[0], v1[1]), pack2(v1[2], v1[3])}; *(u32x4*)(O + (size_t)r * ldo + c) = pk; }
                    else if (aout && c < nvalid + 16) { float* ap = aout + (size_t)r * 16 + (c - nvalid); *(f32x4*)ap = v0; *(f32x4*)(ap + 4) = v1; }
                }
            }
    }
};
struct EpiNull { static constexpr bool PERM = true, AFTER_DRAIN = false; float* sink;
    __device__ __forceinline__ void operator()(const f32x4 (&acc)[2][2][4][2], const pg8::Unit& u, int wr, int wc, int fr, int fq) const {
        float t = 0.f;
#pragma unroll
        for (int ai = 0; ai < 2; ++ai)
#pragma unroll
            for (int bj = 0; bj < 2; ++bj)
#pragma unroll
                for (int m = 0; m < 4; ++m)
#pragma unroll
                    for (int n = 0; n < 2; ++n) t += acc[ai][bj][m][n][0] + acc[ai][bj][m][n][1] + acc[ai][bj][m][n][2] + acc[ai][bj][m][n][3];
        if (t == 1.2345e30f) sink[0] = t;
    } };
template <bool BASE_BF16> struct EpiResid {
    static constexpr bool PERM = false, AFTER_DRAIN = false;
    const void* base; float* out;
    __device__ __forceinline__ void operator()(const f32x4 (&acc)[2][2][4][2], const pg8::Unit& u, int wr, int wc, int fr, int fq) const {
        const int row0 = u.pm * 256 + wr * 64 + fr, col0 = u.pn * 256 + wc * 32 + 4 * fq;
#pragma unroll
        for (int ai = 0; ai < 2; ++ai)
#pragma unroll
            for (int mp = 0; mp < 2; ++mp) {
                f32x4 bv[2][2][2];
#pragma unroll
                for (int mm = 0; mm < 2; ++mm)
#pragma unroll
                    for (int bj = 0; bj < 2; ++bj)
#pragma unroll
                        for (int n = 0; n < 2; ++n) { const size_t idx = (size_t)(row0 + ai * 128 + (mp * 2 + mm) * 16) * 2048 + col0 + bj * 128 + n * 16;
                            if (BASE_BF16) { const u32x2 t = *(const u32x2*)((const bf16_t*)base + idx); bv[mm][bj][n] = (f32x4){bflo(t[0]), bfhi(t[0]), bflo(t[1]), bfhi(t[1])}; }
                            else bv[mm][bj][n] = *(const f32x4*)((const float*)base + idx); }
#pragma unroll
                for (int mm = 0; mm < 2; ++mm)
#pragma unroll
                    for (int bj = 0; bj < 2; ++bj)
#pragma unroll
                        for (int n = 0; n < 2; ++n) *(f32x4*)(out + (size_t)(row0 + ai * 128 + (mp * 2 + mm) * 16) * 2048 + col0 + bj * 128 + n * 16) = bv[mm][bj][n] + acc[ai][bj][mp * 2 + mm][n];
            }
    }
};
template <bool BASE_BF16> struct EpiResidNorm {
    static constexpr bool PERM = false, AFTER_DRAIN = false;
    const void* base; bf16_t* xb; float* sumsq;
    __device__ __forceinline__ void operator()(const f32x4 (&acc)[2][2][4][2], const pg8::Unit& u, int wr, int wc, int fr, int fq) const {
        const int row0 = u.pm * 256 + wr * 64 + fr, col0 = u.pn * 256 + wc * 32 + 4 * fq;
#pragma unroll
        for (int ai = 0; ai < 2; ++ai)
#pragma unroll
            for (int mp = 0; mp < 2; ++mp) {
                f32x4 bv[2][2][2];
#pragma unroll
                for (int mm = 0; mm < 2; ++mm)
#pragma unroll
                    for (int bj = 0; bj < 2; ++bj)
#pragma unroll
                        for (int n = 0; n < 2; ++n) { const size_t idx = (size_t)(row0 + ai * 128 + (mp * 2 + mm) * 16) * 2048 + col0 + bj * 128 + n * 16;
                            if (BASE_BF16) { const u32x2 t = *(const u32x2*)((const bf16_t*)base + idx); bv[mm][bj][n] = (f32x4){bflo(t[0]), bfhi(t[0]), bflo(t[1]), bfhi(t[1])}; }
                            else bv[mm][bj][n] = *(const f32x4*)((const float*)base + idx); }
#pragma unroll
                for (int mm = 0; mm < 2; ++mm) {
                    const int r = row0 + ai * 128 + (mp * 2 + mm) * 16; float ss = 0.f;
#pragma unroll
                    for (int bj = 0; bj < 2; ++bj)
#pragma unroll
                        for (int n = 0; n < 2; ++n) { const size_t idx = (size_t)r * 2048 + col0 + bj * 128 + n * 16; const f32x4 v = bv[mm][bj][n] + acc[ai][bj][mp * 2 + mm][n];
                            u32x2 pk = {pack2(v[0], v[1]), pack2(v[2], v[3])}; *(u32x2*)(xb + idx) = pk; ss += v[0] * v[0] + v[1] * v[1] + v[2] * v[2] + v[3] * v[3]; }
                    ss += __shfl_xor(ss, 16); ss += __shfl_xor(ss, 32);
                    if (fq == 0) __hip_atomic_fetch_add(sumsq + r, ss, __ATOMIC_RELAXED, __HIP_MEMORY_SCOPE_AGENT);
                }
            }
    }
};

constexpr int NTOK = 8192, DM = 2048, SEQ = 4096, DFF = 5632, NIN = 6160, NINP = 6400;
constexpr int LDS_BYTES = 147456;
constexpr size_t al256(size_t x) { return (x + 255) & ~(size_t)255; }
constexpr size_t OFF_WT_IN = 0;
constexpr size_t OFF_WT_GOUT = OFF_WT_IN + al256((size_t)NINP * DM * 2);
constexpr size_t OFF_WT_UP0 = OFF_WT_GOUT + al256((size_t)DM * DM * 2);
constexpr size_t OFF_WT_UP1 = OFF_WT_UP0 + al256((size_t)2 * DFF * DM * 2);
constexpr size_t OFF_WT_DN0 = OFF_WT_UP1 + al256((size_t)2 * DFF * DM * 2);
constexpr size_t OFF_WT_DN1 = OFF_WT_DN0 + al256((size_t)DM * DFF * 2);
constexpr size_t OFF_WT_KVQ = OFF_WT_DN1 + al256((size_t)DM * DFF * 2);
constexpr size_t OFF_WT_AOUT = OFF_WT_KVQ + al256((size_t)10240 * DM * 2);
constexpr size_t OFF_XB = OFF_WT_AOUT + al256((size_t)DM * DM * 2);
constexpr size_t OFF_OG = OFF_XB + al256((size_t)NTOK * DM * 2);
constexpr size_t OFF_RSTD = OFF_OG + al256((size_t)NTOK * DM * 2);
constexpr size_t OFF_AG = OFF_RSTD + al256((size_t)4 * NTOK * 4);
constexpr size_t OFF_DEC = OFF_AG + al256((size_t)NTOK * 16 * 4);
constexpr size_t OFF_LSE = OFF_DEC + al256((size_t)512 * 256 * 4);
constexpr size_t OFF_BAR = OFF_LSE + al256((size_t)3 * NTOK * 16 * 4);
constexpr size_t OFF_R1 = OFF_BAR + al256((size_t)XCD_BAR_WORDS * 4);
constexpr size_t OFF_R2 = OFF_R1 + al256((size_t)NTOK * 2 * DFF * 2);
constexpr size_t OFF_OGLA = OFF_R2;
constexpr size_t OFF_QD = OFF_OGLA + al256((size_t)NTOK * DM * 4);
constexpr size_t OFF_KTE = OFF_QD + al256((size_t)NTOK * 1024 * 2);
constexpr size_t OFF_PSC = OFF_KTE + al256((size_t)NTOK * 1024 * 2);
constexpr size_t R2_GLA_END = OFF_PSC + al256((size_t)512 * 4096 * 2);
constexpr size_t OFF_ACT = OFF_R2;
constexpr size_t OFF_ATTO = OFF_R2;
constexpr size_t R2_SIZE = (R2_GLA_END - OFF_R2) > (size_t)3 * NTOK * DM * 2 ? (R2_GLA_END - OFF_R2) : (size_t)3 * NTOK * DM * 2;
constexpr size_t WS_END = OFF_R2 + R2_SIZE;

struct P {
    const float* x; const float* attn_norm; const float* gla_w_in; const float* gla_w_a2; const float* gla_b_a2; const float* gla_head_norm; const float* gla_w_out;
    const float* kv_norm; const float* w_kv; const float* dsa_w_q; const float* dsa_w_out; const float* ffn_norm; const float* ffn_w_up; const float* ffn_conv_w;
    const float* ffn_conv_b; const float* ffn_w_down; const float* final_norm;
    float* out; unsigned char* ws; int ph_lo, ph_hi;
};

__device__ __forceinline__ void convert_job(const float* __restrict__ W, int ldw, int K, int N, const float* __restrict__ gain, bf16_t* __restrict__ Wt, int& g, int& base, LAS unsigned char* lds) {
    const int nkb = K / 128, ntiles = (N / 64) * nkb;
    const int tid = threadIdx.x;
    LAS bf16_t* T = (LAS bf16_t*)lds;
    const int n4 = tid & 15, kr = tid >> 4;
    while (g < base + ntiles) {
        const int t = g - base; const int nb = t / nkb, kb = t - nb * nkb;
        const int n0 = nb * 64, k0 = kb * 128;
        f32x4 v[4]; float gn[4];
#pragma unroll
        for (int q = 0; q < 4; ++q) { const int k = k0 + kr + 32 * q; v[q] = __builtin_nontemporal_load((const f32x4*)(W + (size_t)k * ldw + n0 + n4 * 4)); gn[q] = gain ? gain[k] : 1.f; }
#pragma unroll
        for (int q = 0; q < 4; ++q)
#pragma unroll
            for (int j = 0; j < 4; ++j) T[(n4 * 4 + j) * 136 + kr + 32 * q] = f2bf(v[q][j] * gn[q]);
        __syncthreads();
#pragma unroll
        for (int q = 0; q < 2; ++q) { const int c = tid + 512 * q; const int n = c >> 4, kc = c & 15; const u32x4 dd = *(const LAS u32x4*)(T + n * 136 + kc * 8); __builtin_nontemporal_store(dd, (u32x4*)(Wt + (size_t)(n0 + n) * K + k0 + kc * 8)); }
        __syncthreads();
        g += gridDim.x;
    }
    base += ntiles;
}

__device__ __forceinline__ void norm_pass(const float* __restrict__ src, bf16_t* __restrict__ dst, float* __restrict__ rstd) {
    const int lane = threadIdx.x & 63, wave = threadIdx.x >> 6;
    const int row0 = blockIdx.x * 8 + wave, rstep = gridDim.x * 8;
    f32x4 nv[8];
#pragma unroll
    for (int i = 0; i < 8; ++i) nv[i] = (f32x4){0.f, 0.f, 0.f, 0.f};
    if (row0 < NTOK) {
#pragma unroll
        for (int i = 0; i < 8; ++i) nv[i] = __builtin_nontemporal_load((const f32x4*)(src + (size_t)row0 * DM + (i * 64 + lane) * 4));
    }
    for (int row = row0; row < NTOK; row += rstep) {
        f32x4 v[8]; float ss = 0.f;
#pragma unroll
        for (int i = 0; i < 8; ++i) { v[i] = nv[i]; ss += v[i][0] * v[i][0] + v[i][1] * v[i][1] + v[i][2] * v[i][2] + v[i][3] * v[i][3]; }
        if (row + rstep < NTOK) {
#pragma unroll
            for (int i = 0; i < 8; ++i) nv[i] = __builtin_nontemporal_load((const f32x4*)(src + (size_t)(row + rstep) * DM + (i * 64 + lane) * 4));
        }
        ss = wave_sum(ss);
        if (lane == 0) rstd[row] = ss;
#pragma unroll
        for (int i = 0; i < 8; ++i) { u32x2 pk = {pack2(v[i][0], v[i][1]), pack2(v[i][2], v[i][3])}; *(u32x2*)(dst + (size_t)row * DM + (i * 64 + lane) * 4) = pk; }
    }
}

__device__ __forceinline__ void final_norm_pass(float* h, const float* __restrict__ gain) {
    const int lane = threadIdx.x & 63, wave = threadIdx.x >> 6;
    const int row0 = blockIdx.x * 8 + wave, rstep = gridDim.x * 8;
    f32x4 gg[8], nv[8];
#pragma unroll
    for (int i = 0; i < 8; ++i) { gg[i] = *(const f32x4*)(gain + (i * 64 + lane) * 4); nv[i] = (f32x4){0.f, 0.f, 0.f, 0.f}; }
    if (row0 < NTOK) {
#pragma unroll
        for (int i = 0; i < 8; ++i) nv[i] = *(const f32x4*)(h + (size_t)row0 * DM + (i * 64 + lane) * 4);
    }
    for (int row = row0; row < NTOK; row += rstep) {
        float* s = h + (size_t)row * DM; f32x4 v[8]; float ss = 0.f;
#pragma unroll
        for (int i = 0; i < 8; ++i) { v[i] = nv[i]; ss += v[i][0] * v[i][0] + v[i][1] * v[i][1] + v[i][2] * v[i][2] + v[i][3] * v[i][3]; }
        if (row + rstep < NTOK) {
#pragma unroll
            for (int i = 0; i < 8; ++i) nv[i] = *(const f32x4*)(h + (size_t)(row + rstep) * DM + (i * 64 + lane) * 4);
        }
        ss = wave_sum(ss);
        const float rs = rsqrtf(ss * (1.f / DM) + 1e-6f);
#pragma unroll
        for (int i = 0; i < 8; ++i) *(f32x4*)(s + (i * 64 + lane) * 4) = v[i] * rs * gg[i];
    }
}

constexpr int CONV_BATCHES = (2 * (512 + 2816 + 1408) + 1024 + 1536) / 4;
__device__ __forceinline__ bool conv_locate(const P& p, int g, const float*& W, int& ldw, int& K, const float*& gain, bf16_t*& Wt, int& t) {
    unsigned char* ws = p.ws; int base = 0;
#define CJ(Wp, LDW, KK, NN, GP, DST) { const int nt_ = ((NN) / 128) * ((KK) / 256); if (g < base + nt_) { W = (Wp); ldw = (LDW); K = (KK); gain = (GP); Wt = (bf16_t*)(DST); t = g - base; return true; } base += nt_; }
    CJ(p.gla_w_out, DM, DM, DM, nullptr, ws + OFF_WT_GOUT)
    CJ(p.ffn_w_up, 2 * DFF, DM, 2 * DFF, p.ffn_norm, ws + OFF_WT_UP0)
    CJ(p.ffn_w_down, DM, DFF, DM, nullptr, ws + OFF_WT_DN0)
    CJ(p.w_kv, 4096, DM, 4096, p.kv_norm, ws + OFF_WT_KVQ)
    CJ(p.dsa_w_q, 6144, DM, 6144, p.attn_norm + DM, ws + OFF_WT_KVQ + (size_t)4096 * DM * 2)
    CJ(p.dsa_w_out, DM, DM, DM, nullptr, ws + OFF_WT_AOUT)
    CJ(p.ffn_w_up + (size_t)DM * 2 * DFF, 2 * DFF, DM, 2 * DFF, p.ffn_norm + DM, ws + OFF_WT_UP1)
    CJ(p.ffn_w_down + (size_t)DFF * DM, DM, DFF, DM, nullptr, ws + OFF_WT_DN1)
#undef CJ
    return false;
}

__device__ __forceinline__ int conv_nb2(const P& p, const float* W) {
    if (W == p.ffn_w_up || W == p.ffn_w_up + (size_t)DM * 2 * DFF) return 2 * DFF / 128;
    if (W == p.w_kv) return 4096 / 128;
    if (W == p.dsa_w_q) return 6144 / 128;
    return DM / 128;
}

__device__ __forceinline__ void phase_prologue(const P& p, LAS unsigned char* lds) {
    unsigned char* ws = p.ws;
    norm_pass(p.x, (bf16_t*)(ws + OFF_XB), (float*)(ws + OFF_RSTD));
    {
        bf16_t* wt = (bf16_t*)(ws + OFF_WT_IN);
        for (int i = blockIdx.x * 512 + threadIdx.x; i < 16 * DM; i += gridDim.x * 512) {
            const int j = i >> 11, k = i & 2047; const float v = p.gla_w_in[(size_t)k * NIN + 6144 + j] * p.attn_norm[k];
            wt[(size_t)(6144 + j) * DM + k] = f2bf(v);
        }
        float* ssz = (float*)(ws + OFF_RSTD) + NTOK;
        for (int i = blockIdx.x * 512 + threadIdx.x; i < 3 * NTOK; i += gridDim.x * 512) ssz[i] = 0.f;
    }
    int g = blockIdx.x, base = 0;
    convert_job(p.gla_w_in, NIN, DM, 6144, p.attn_norm, (bf16_t*)(ws + OFF_WT_IN), g, base, lds);
}

__device__ __forceinline__ void gla_prep(const P& p, LAS unsigned char* lds) {
    unsigned char* ws = p.ws;
    const bf16_t* PROJ = (const bf16_t*)(ws + OFF_R1); const bf16_t* XB = (const bf16_t*)(ws + OFF_XB); const bf16_t* WA = (const bf16_t*)(ws + OFF_WT_IN) + (size_t)6144 * DM; const float* SS0 = (const float*)(ws + OFF_RSTD);
    bf16_t* QD = (bf16_t*)(ws + OFF_QD); bf16_t* KTE = (bf16_t*)(ws + OFF_KTE); bf16_t* PSC = (bf16_t*)(ws + OFF_PSC); float* DEC = (float*)(ws + OFF_DEC);
    LAS bf16_t* sQ = (LAS bf16_t*)lds;
    LAS bf16_t* sK = sQ + 64 * 264;
    LAS float* sTot = (LAS float*)(lds + 2 * 64 * 264 * 2);
    LAS float* sAp = sTot + 512;
    LAS float* sAf = sAp + 2048;
    const int tid = threadIdx.x, kcol = tid & 255, half = __builtin_amdgcn_readfirstlane(tid >> 8);
    const int lane = tid & 63, wid = __builtin_amdgcn_readfirstlane(tid >> 6), fr = lane & 15, fq = lane >> 4;
    for (int item = blockIdx.x; item < 512; item += gridDim.x) {
        const int n = item & 63, h = (item >> 6) & 3, b = item >> 8;
        const int tok0 = b * SEQ + n * 64;
        {
            const int tt4 = wid & 3, kh = wid >> 2; f32x4 aacc = {0.f, 0.f, 0.f, 0.f};
            const bf16_t* arow = XB + (size_t)(tok0 + tt4 * 16 + fr) * DM + kh * 1024 + fq * 8;
            const bf16_t* brow = WA + (size_t)fr * DM + kh * 1024 + fq * 8;
            for (int kb0 = 0; kb0 < 32; kb0 += 16) {
                bf16x8 af[16], bfr[16];
#pragma unroll
                for (int i = 0; i < 16; ++i) { af[i] = *(const bf16x8*)(arow + (kb0 + i) * 32); bfr[i] = *(const bf16x8*)(brow + (kb0 + i) * 32); }
#pragma unroll
                for (int i = 0; i < 16; ++i) aacc = __builtin_amdgcn_mfma_f32_16x16x32_bf16(af[i], bfr[i], aacc, 0, 0, 0);
            }
#pragma unroll
            for (int j = 0; j < 4; ++j) sAp[kh * 1024 + (tt4 * 16 + 4 * fq + j) * 16 + fr] = aacc[j];
            __syncthreads();
#pragma unroll
            for (int q = 0; q < 2; ++q) { const int idx = tid + 512 * q; sAf[idx] = (sAp[idx] + sAp[1024 + idx]) * rsqrtf(SS0[tok0 + (idx >> 4)] * (1.f / 2048.f) + 1e-6f); }
            __syncthreads();
        }
        bf16_t qraw[32], kraw[32];
#pragma unroll
        for (int tt = 0; tt < 32; ++tt) { const size_t tok = (size_t)(tok0 + half * 32 + tt); qraw[tt] = __builtin_nontemporal_load(PROJ + tok * 6144 + h * 256 + kcol); kraw[tt] = __builtin_nontemporal_load(PROJ + tok * 6144 + 1024 + h * 256 + kcol); }
        float w2[16];
#pragma unroll
        for (int j = 0; j < 16; ++j) w2[j] = p.gla_w_a2[j * 1024 + h * 256 + kcol];
        const float bias = p.gla_b_a2[h * 256 + kcol];
        float cum[32]; float run = 0.f;
#pragma unroll
        for (int tt = 0; tt < 32; ++tt) {
            const LAS float* ap = sAf + (half * 32 + tt) * 16; float xg = bias;
#pragma unroll
            for (int j = 0; j < 16; ++j) xg += ap[j] * w2[j];
            const float ls = fminf(xg, 0.f) - __logf(1.f + __expf(-fabsf(xg)));
            run += ls * (1.f / 16.f); cum[tt] = run;
        }
        sTot[half * 256 + kcol] = run;
        __syncthreads();
        const float tot0 = sTot[kcol], tot1 = sTot[256 + kcol]; const float last = tot0 + tot1; const float off = half ? tot0 : 0.f;
        unsigned ktp[16];
#pragma unroll
        for (int tt = 0; tt < 32; ++tt) {
            const float c = cum[tt] + off; const int tok = tok0 + half * 32 + tt;
            const float q = bf2f(qraw[tt]); const float k = bf2f(kraw[tt]);
            const float qd = q * 0.0625f * __expf(c); const float ki = k * __expf(-c); const float kte = k * __expf(last - c);
            const bf16_t qb = f2bf(qd); QD[(((size_t)item * 8 + (kcol >> 5)) * 64 + half * 32 + tt) * 32 + (kcol & 31)] = qb;
            sQ[(half * 32 + tt) * 264 + kcol] = qb; sK[(half * 32 + tt) * 264 + kcol] = f2bf(ki);
            if (tt & 1) ktp[tt >> 1] |= ((unsigned)f2bf(kte)) << 16; else ktp[tt >> 1] = (unsigned)f2bf(kte);
        }
        {
            u32x4* dst = (u32x4*)(KTE + ((size_t)item * 256 + kcol) * 64 + half * 32);
#pragma unroll
            for (int i = 0; i < 4; ++i) { u32x4 vv = {ktp[4 * i], ktp[4 * i + 1], ktp[4 * i + 2], ktp[4 * i + 3]}; dst[i] = vv; }
        }
        if (half == 0) DEC[item * 256 + kcol] = __expf(last);
        __syncthreads();
        const int ttile = wid >> 1;
#pragma unroll
        for (int i = 0; i < 2; ++i) {
            const int st = (wid & 1) * 2 + i; f32x4 acc = {0.f, 0.f, 0.f, 0.f};
#pragma unroll
            for (int kb = 0; kb < 8; ++kb) {
                const bf16x8 a = *(const LAS bf16x8*)(sK + (st * 16 + fr) * 264 + kb * 32 + fq * 8);
                const bf16x8 bq = *(const LAS bf16x8*)(sQ + (ttile * 16 + fr) * 264 + kb * 32 + fq * 8);
                acc = __builtin_amdgcn_mfma_f32_16x16x32_bf16(a, bq, acc, 0, 0, 0);
            }
            const int t = ttile * 16 + fr, s0 = st * 16 + 4 * fq;
            const float v0 = (s0 + 0 <= t) ? acc[0] : 0.f, v1 = (s0 + 1 <= t) ? acc[1] : 0.f, v2 = (s0 + 2 <= t) ? acc[2] : 0.f, v3 = (s0 + 3 <= t) ? acc[3] : 0.f;
            u32x2 pk = {pack2(v0, v1), pack2(v2, v3)};
            *(u32x2*)(PSC + (((size_t)item * 2 + (s0 >> 5)) * 64 + t) * 32 + (s0 & 31)) = pk;
        }
        __syncthreads();
    }
}

__device__ __forceinline__ void gla_scan(const P& p, LAS unsigned char* lds, const int mode = 3) {
    unsigned char* ws = p.ws;
    const bf16_t* PROJ = (const bf16_t*)(ws + OFF_R1);
    const bf16_t* QD = (const bf16_t*)(ws + OFF_QD); const bf16_t* KTE = (const bf16_t*)(ws + OFF_KTE); const bf16_t* PSC = (const bf16_t*)(ws + OFF_PSC); const float* DEC = (const float*)(ws + OFF_DEC);
    float* OGLA = (float*)(ws + OFF_OGLA);
    LAS bf16_t* sVT = (LAS bf16_t*)lds;
    LAS bf16_t* sST = sVT + 32 * 72;
    LAS bf16_t* sT = (LAS bf16_t*)(lds + 24576);
    const int tid = threadIdx.x, lane = tid & 63, wid = __builtin_amdgcn_readfirstlane(tid >> 6), fr = lane & 15, fq = lane >> 4;
    const int n4 = tid & 15, kr = tid >> 4;
    const int bid = blockIdx.x; const bool split = (gridDim.x % 16 == 0);
    const int role = split ? ((bid >> 3) & 1) : 0; const int ridx = split ? (((bid >> 4) << 3) | (bid & 7)) : bid; const int nrole = split ? (int)gridDim.x / 2 : (int)gridDim.x;
    if (role == 0 && (mode & 1)) {
    const int sw = wid & 3;
    const int item0 = (gridDim.x == 256) ? ((bid & 7) * 16 + (bid >> 4)) : ridx;
    for (int item = item0; item < 128; item += nrole) {
        const int vs = item & 15, bh = item >> 4; const int h = bh & 3, b = bh >> 2;
        for (int i = tid; i < 32 * 264 / 2; i += 512) ((LAS unsigned*)sST)[i] = 0u;
        f32x4 S[2][4];
#pragma unroll
        for (int v = 0; v < 2; ++v)
#pragma unroll
            for (int i = 0; i < 4; ++i) S[v][i] = (f32x4){0.f, 0.f, 0.f, 0.f};
        u32x4 vrA = {0u, 0u, 0u, 0u}, vrB = {0u, 0u, 0u, 0u}; bf16x8 xfA[10], xfB[10]; float dA[4], dB[4];
#pragma unroll
        for (int k = 0; k < 10; ++k) { xfA[k] = (bf16x8){0, 0, 0, 0, 0, 0, 0, 0}; xfB[k] = xfA[k]; }
#pragma unroll
        for (int k = 0; k < 4; ++k) { dA[k] = 0.f; dB[k] = 0.f; }
#define GLA_LOAD(nn, VR, XF, DD) do { const int _tok0 = b * SEQ + (nn) * 64; const size_t _bhn = (size_t)bh * 64 + (nn); \
        if (tid < 256) VR = __builtin_nontemporal_load((const u32x4*)(PROJ + (size_t)(_tok0 + (tid >> 2)) * 6144 + 2048 + h * 512 + vs * 32 + (tid & 3) * 8)); \
        if (wid < 4) { \
            _Pragma("unroll") for (int _k = 0; _k < 8; ++_k) XF[_k] = *(const bf16x8*)(QD + ((_bhn * 8 + _k) * 64 + 16 * sw + fr) * 32 + fq * 8); \
            _Pragma("unroll") for (int _s = 0; _s < 2; ++_s) XF[8 + _s] = *(const bf16x8*)(PSC + ((_bhn * 2 + _s) * 64 + 16 * sw + fr) * 32 + fq * 8); \
        } else { \
            _Pragma("unroll") for (int _i = 0; _i < 4; ++_i) { _Pragma("unroll") for (int _t = 0; _t < 2; ++_t) XF[_i * 2 + _t] = *(const bf16x8*)(KTE + (_bhn * 256 + (4 * sw + _i) * 16 + fr) * 64 + _t * 32 + fq * 8); \
                DD[_i] = DEC[_bhn * 256 + (4 * sw + _i) * 16 + fr]; } } } while (0)
#define GLA_STEP(nn, VR, XF, DD, NEXTLOAD) do { \
        if (tid < 256) { const int _t = tid >> 2, _hv = tid & 3; \
            _Pragma("unroll") for (int _j = 0; _j < 4; ++_j) { sVT[(_hv * 8 + 2 * _j) * 72 + _t] = (bf16_t)(VR[_j] & 0xFFFFu); sVT[(_hv * 8 + 2 * _j + 1) * 72 + _t] = (bf16_t)(VR[_j] >> 16); } } \
        NEXTLOAD; \
        LDS_BARRIER(); \
        if (wid < 4) { \
            _Pragma("unroll") for (int _v = 0; _v < 2; ++_v) { f32x4 _a0 = {0.f, 0.f, 0.f, 0.f}, _a1 = {0.f, 0.f, 0.f, 0.f}; \
                _Pragma("unroll") for (int _sb = 0; _sb < 2; ++_sb) { const bf16x8 _a = *(const LAS bf16x8*)(sVT + (_v * 16 + fr) * 72 + _sb * 32 + fq * 8); if (_sb) _a1 = __builtin_amdgcn_mfma_f32_16x16x32_bf16(_a, XF[8 + _sb], _a1, 0, 0, 0); else _a0 = __builtin_amdgcn_mfma_f32_16x16x32_bf16(_a, XF[8 + _sb], _a0, 0, 0, 0); } \
                _Pragma("unroll") for (int _kb = 0; _kb < 8; ++_kb) { const bf16x8 _a = *(const LAS bf16x8*)(sST + (_v * 16 + fr) * 264 + _kb * 32 + fq * 8); if (_kb & 1) _a1 = __builtin_amdgcn_mfma_f32_16x16x32_bf16(_a, XF[_kb], _a1, 0, 0, 0); else _a0 = __builtin_amdgcn_mfma_f32_16x16x32_bf16(_a, XF[_kb], _a0, 0, 0, 0); } \
                *(f32x4*)(OGLA + (size_t)(b * SEQ + (nn) * 64 + 16 * sw + fr) * DM + h * 512 + vs * 32 + _v * 16 + 4 * fq) = _a0 + _a1; } \
        } else { \
            _Pragma("unroll") for (int _i = 0; _i < 4; ++_i) { S[0][_i] *= DD[_i]; S[1][_i] *= DD[_i]; } \
            _Pragma("unroll") for (int _tb = 0; _tb < 2; ++_tb) { const bf16x8 _a = *(const LAS bf16x8*)(sVT + fr * 72 + _tb * 32 + fq * 8); const bf16x8 _b = *(const LAS bf16x8*)(sVT + (16 + fr) * 72 + _tb * 32 + fq * 8); \
                _Pragma("unroll") for (int _i = 0; _i < 4; ++_i) { S[0][_i] = __builtin_amdgcn_mfma_f32_16x16x32_bf16(_a, XF[_i * 2 + _tb], S[0][_i], 0, 0, 0); S[1][_i] = __builtin_amdgcn_mfma_f32_16x16x32_bf16(_b, XF[_i * 2 + _tb], S[1][_i], 0, 0, 0); } } } \
        LDS_BARRIER(); \
        if (wid >= 4) { _Pragma("unroll") for (int _v = 0; _v < 2; ++_v) _Pragma("unroll") for (int _i = 0; _i < 4; ++_i) _Pragma("unroll") for (int _j = 0; _j < 4; ++_j) \
            sST[(_v * 16 + 4 * fq + _j) * 264 + (4 * sw + _i) * 16 + fr] = f2bf(S[_v][_i][_j]); } } while (0)
        GLA_LOAD(0, vrA, xfA, dA);
        for (int n = 0; n < 64; n += 2) {
            GLA_STEP(n, vrA, xfA, dA, GLA_LOAD(n + 1, vrB, xfB, dB));
            GLA_STEP(n + 1, vrB, xfB, dB, if (n + 2 < 64) GLA_LOAD(n + 2, vrA, xfA, dA));
        }
#undef GLA_LOAD
#undef GLA_STEP
        LDS_BARRIER();
    }
    }
    if ((role == 1 || !split) && (mode & 2)) {
        int cg_next = ridx; f32x4 cv[4][4]; float cgn[4][4]; bool c_have[4]; bf16_t* c_dst[4]; int c_K[4];
#pragma unroll
        for (int u = 0; u < 4; ++u) { c_have[u] = false; c_dst[u] = nullptr; c_K[u] = 0;
#pragma unroll
            for (int q = 0; q < 4; ++q) { cv[u][q] = (f32x4){0.f, 0.f, 0.f, 0.f}; cgn[u][q] = 1.f; } }
#define CONV_ISSUE_ALL() do { const float* _W = nullptr; const float* _gp = nullptr; bf16_t* _Wt = nullptr; int _ldw = 0, _K = 0, _bt = 0; \
        const bool _hv = (cg_next < CONV_BATCHES) && conv_locate(p, cg_next, _W, _ldw, _K, _gp, _Wt, _bt); cg_next += nrole; \
        _Pragma("unroll") for (int _u = 0; _u < 4; ++_u) c_have[_u] = _hv; \
        if (_hv) { const int _nb4cnt = conv_nb2(p, _W) >> 1; const int _kb = _bt / _nb4cnt, _nb4 = _bt - _kb * _nb4cnt;     \
            _Pragma("unroll") for (int _u = 0; _u < 4; ++_u) { const int _n0 = (4 * _nb4 + _u) * 64, _k0 = _kb * 128; c_K[_u] = _K; c_dst[_u] = _Wt + (size_t)_n0 * _K + _k0; \
                _Pragma("unroll") for (int _q = 0; _q < 4; ++_q) { const int _k = _k0 + 4 * kr + _q; cv[_u][_q] = __builtin_nontemporal_load((const f32x4*)(_W + (size_t)_k * _ldw + _n0 + n4 * 4)); cgn[_u][_q] = _gp ? _gp[_k] : 1.f; } } } } while (0)
        CONV_ISSUE_ALL();
        while (c_have[0]) {
            bf16_t* cd[4]; int cK[4]; bool ch[4];
#pragma unroll
            for (int u = 0; u < 4; ++u) { cd[u] = c_dst[u]; cK[u] = c_K[u]; ch[u] = c_have[u];
                if (ch[u]) {
#pragma unroll
                    for (int j = 0; j < 4; ++j) {
                        u32x2 pk = {pack2(cv[u][0][j] * cgn[u][0], cv[u][1][j] * cgn[u][1]), pack2(cv[u][2][j] * cgn[u][2], cv[u][3][j] * cgn[u][3])};
                        *(LAS u32x2*)(sT + u * (64 * 132) + (n4 * 4 + j) * 132 + 4 * kr) = pk;
                    }
                } }
            CONV_ISSUE_ALL();
            LDS_BARRIER();
#pragma unroll
            for (int u = 0; u < 4; ++u) if (ch[u]) {
#pragma unroll
                for (int q = 0; q < 2; ++q) { const int c = tid + 512 * q; const int n = c >> 4, kc = c & 15; const u32x2 d0 = *(const LAS u32x2*)(sT + u * (64 * 132) + n * 132 + kc * 8), d1 = *(const LAS u32x2*)(sT + u * (64 * 132) + n * 132 + kc * 8 + 4); const u32x4 dd = {d0[0], d0[1], d1[0], d1[1]}; __builtin_nontemporal_store(dd, (u32x4*)(cd[u] + (size_t)n * cK[u] + kc * 8)); }
            }
            LDS_BARRIER();
        }
#undef CONV_ISSUE_ALL
    }
}

__device__ __forceinline__ void gla_gate(const P& p) {
    unsigned char* ws = p.ws;
    const bf16_t* PROJ = (const bf16_t*)(ws + OFF_R1); const float* OGLA = (const float*)(ws + OFF_OGLA); bf16_t* OG = (bf16_t*)(ws + OFF_OG);
    const int lane = threadIdx.x & 63, wave = threadIdx.x >> 6;
    float hn[8];
#pragma unroll
    for (int j = 0; j < 8; ++j) hn[j] = p.gla_head_norm[lane * 8 + j];
    f32x4 no0 = {0.f, 0.f, 0.f, 0.f}, no1 = no0; u32x4 nrr = {0u, 0u, 0u, 0u};
#define GATE_LOAD(task_) do { const int _tok = (task_) >> 2, _h = (task_) & 3; const float* _op = OGLA + (size_t)_tok * DM + _h * 512 + lane * 8; \
        no0 = __builtin_nontemporal_load((const f32x4*)_op); no1 = __builtin_nontemporal_load((const f32x4*)(_op + 4)); nrr = __builtin_nontemporal_load((const u32x4*)(PROJ + (size_t)_tok * 6144 + 4096 + _h * 512 + lane * 8)); } while (0)
    const int task0 = blockIdx.x * 8 + wave, tstep = gridDim.x * 8;
    if (task0 < NTOK * 4) GATE_LOAD(task0);
    for (int task = task0; task < NTOK * 4; task += tstep) {
        const int tok = task >> 2, h = task & 3;
        const f32x4 o0 = no0, o1 = no1; const u32x4 rr = nrr;
        if (task + tstep < NTOK * 4) GATE_LOAD(task + tstep);
        float ss = o0[0] * o0[0] + o0[1] * o0[1] + o0[2] * o0[2] + o0[3] * o0[3] + o1[0] * o1[0] + o1[1] * o1[1] + o1[2] * o1[2] + o1[3] * o1[3];
        ss = wave_sum(ss);
        const float rs = rsqrtf(ss * (1.f / 512.f) + 1e-6f);
        float o[8] = {o0[0], o0[1], o0[2], o0[3], o1[0], o1[1], o1[2], o1[3]};
        float r[8] = {bflo(rr[0]), bfhi(rr[0]), bflo(rr[1]), bfhi(rr[1]), bflo(rr[2]), bfhi(rr[2]), bflo(rr[3]), bfhi(rr[3])};
        float y[8];
#pragma unroll
        for (int j = 0; j < 8; ++j) { const float sg = __fdividef(r[j], 1.f + __expf(-r[j])); y[j] = o[j] * rs * hn[j] * sg; }
        u32x4 pk = {pack2(y[0], y[1]), pack2(y[2], y[3]), pack2(y[4], y[5]), pack2(y[6], y[7])};
        *(u32x4*)(OG + (size_t)tok * DM + h * 512 + lane * 8) = pk;
    }
#undef GATE_LOAD
}

__device__ __forceinline__ float gelu_erf(float v) {
    const float av = fabsf(v), dd = av * 0.2316418882f + 1.0f;
    const float t = __builtin_amdgcn_rcpf(dd);
    float q = t * 0.5307027145f + (-0.7265760135f); q = q * t + 0.7107068705f; q = q * t + (-0.142248368f); q = q * t + 0.127414796f; q = q * t;
    const float e = __builtin_amdgcn_exp2f(v * v * (-0.72134752044f));
    const float mm = v * (q * e), rr = v - mm;
    return v < 0.f ? mm : rr;
}

__device__ __forceinline__ void convglu(const bf16_t* __restrict__ UG, bf16_t* __restrict__ ACT, const float* __restrict__ cw, const float* __restrict__ cb) {
    const int gtid = blockIdx.x * 512 + threadIdx.x, nth = gridDim.x * 512;
    for (int T = gtid; T < 512 * 704; T += nth) {
        const int run = T / 704, cgi = T - run * 704; const int c0 = cgi * 8, t0 = run * 16;
        float w0[8], w1[8], w2[8], bb[8], gm2[8], gm1[8];
#pragma unroll
        for (int j = 0; j < 8; ++j) { w0[j] = cw[c0 + j]; w1[j] = cw[DFF + c0 + j]; w2[j] = cw[2 * DFF + c0 + j]; bb[j] = cb[c0 + j]; gm2[j] = 0.f; gm1[j] = 0.f; }
        if ((t0 & (SEQ - 1)) != 0) {
            const u32x4 a = *(const u32x4*)(UG + (size_t)(t0 - 2) * (2 * DFF) + DFF + c0), c = *(const u32x4*)(UG + (size_t)(t0 - 1) * (2 * DFF) + DFF + c0);
#pragma unroll
            for (int j = 0; j < 4; ++j) { gm2[2 * j] = bflo(a[j]); gm2[2 * j + 1] = bfhi(a[j]); gm1[2 * j] = bflo(c[j]); gm1[2 * j + 1] = bfhi(c[j]); }
        }
#pragma unroll 4
        for (int tt = 0; tt < 16; ++tt) {
            const size_t tok = (size_t)(t0 + tt);
            const u32x4 gu = __builtin_nontemporal_load((const u32x4*)(UG + tok * (2 * DFF) + DFF + c0)), uu = __builtin_nontemporal_load((const u32x4*)(UG + tok * (2 * DFF) + c0));
            float gv[8], uv[8], y[8];
#pragma unroll
            for (int j = 0; j < 4; ++j) { gv[2 * j] = bflo(gu[j]); gv[2 * j + 1] = bfhi(gu[j]); uv[2 * j] = bflo(uu[j]); uv[2 * j + 1] = bfhi(uu[j]); }
#pragma unroll
            for (int j = 0; j < 8; ++j) { const float xv = w0[j] * gm2[j] + w1[j] * gm1[j] + w2[j] * gv[j] + bb[j]; y[j] = gelu_erf(xv) * uv[j]; gm2[j] = gm1[j]; gm1[j] = gv[j]; }
            u32x4 pk = {pack2(y[0], y[1]), pack2(y[2], y[3]), pack2(y[4], y[5]), pack2(y[6], y[7])};
            *(u32x4*)(ACT + tok * DFF + c0) = pk;
        }
    }
}

__device__ __forceinline__ void attn_phase(const P& p, LAS unsigned char* lds) {
    unsigned char* ws = p.ws;
    const bf16_t* KVQ = (const bf16_t*)(ws + OFF_R1); bf16_t* ATTO = (bf16_t*)(ws + OFF_ATTO); float* LSE = (float*)(ws + OFF_LSE);
    LAS bf16_t* sK = (LAS bf16_t*)lds;
    LAS bf16_t* sV = sK + 256 * 136;
    const int tid = threadIdx.x, lane = tid & 63, wid = __builtin_amdgcn_readfirstlane(tid >> 6), fr = lane & 15, fq = lane >> 4;
    const int ch = tid & 15, r0 = tid >> 4;
    u32x4 kk[8], vv[8]; bf16x8 qn[4];
#define ATT_DECODE(it, G, B_, H_, DL, QB, TB) const int G = (it) >> 10, B_ = ((it) >> 9) & 1, H_ = ((it) >> 5) & 15, DL = 2 * G; const int QB = ((it) & 31) & ((32 >> DL) - 1); const int TB = B_ * SEQ + (((it) & 31) >> (5 - DL));
#define ATT_LOADK(it) do { ATT_DECODE(it, _g, _b, _h, _dl, _qb, _tb) \
        _Pragma("unroll") for (int _ps = 0; _ps < 8; ++_ps) { const int _ik = (_qb - 1) * 128 + _ps * 32 + r0; \
            if (_ik >= 0) kk[_ps] = *(const u32x4*)(KVQ + (size_t)(_tb + (_ik << _dl)) * 10240 + _h * 128 + ch * 8); else kk[_ps] = (u32x4){0u, 0u, 0u, 0u}; } \
        { const bf16_t* _qs = KVQ + (size_t)(_tb + ((_qb * 128 + 16 * wid + fr) << _dl)) * 10240 + 4096 + _g * 2048 + _h * 128; \
          _Pragma("unroll") for (int _eb = 0; _eb < 4; ++_eb) qn[_eb] = __builtin_nontemporal_load((const bf16x8*)(_qs + _eb * 32 + fq * 8)); } } while (0)
#define ATT_LOADV(it) do { ATT_DECODE(it, _g, _b, _h, _dl, _qb, _tb) \
        _Pragma("unroll") for (int _ps = 0; _ps < 8; ++_ps) { const int _ik = (_qb - 1) * 128 + _ps * 32 + r0; \
            if (_ik >= 0) vv[_ps] = *(const u32x4*)(KVQ + (size_t)(_tb + (_ik << _dl)) * 10240 + 2048 + _h * 128 + ch * 8); else vv[_ps] = (u32x4){0u, 0u, 0u, 0u}; } } while (0)
    const bool xmap = (gridDim.x == 256); const int xcd = (int)blockIdx.x & 7, cu = (int)blockIdx.x >> 3;
    const int nsteps = xmap ? 12 : (((int)blockIdx.x < 3072) ? (3072 - 1 - (int)blockIdx.x) / (int)gridDim.x + 1 : 0);
#define ATT_ITEM(s) (xmap ? ((((((s) % 3) * 2 + ((xcd * 4 + (s) / 3) >> 4)) * 16 + ((xcd * 4 + (s) / 3) & 15)) * 32) + cu) : ((int)blockIdx.x + (s) * (int)gridDim.x))
    if (nsteps > 0) { const int it0 = ATT_ITEM(0); ATT_LOADK(it0); }
    for (int st = 0; st < nsteps; ++st) {
        const int item = ATT_ITEM(st); const int item_next = (st + 1 < nsteps) ? ATT_ITEM(st + 1) : -1;
        ATT_DECODE(item, g, b, h, dl, qb, tokbase)
#pragma unroll
        for (int ps = 0; ps < 8; ++ps) *(LAS u32x4*)(sK + (ps * 32 + r0) * 136 + ch * 8) = kk[ps];
        bf16x8 qf[4];
#pragma unroll
        for (int eb = 0; eb < 4; ++eb) qf[eb] = qn[eb];
        ATT_LOADV(item);
        LDS_BARRIER();
        const int iq = qb * 128 + 16 * wid + fr; const int tokq = tokbase + (iq << dl);
        f32x4 sc[9];
#pragma unroll
        for (int i = 0; i < 9; ++i) {
            f32x4 acc = {0.f, 0.f, 0.f, 0.f};
#pragma unroll
            for (int eb = 0; eb < 4; ++eb) { const bf16x8 a = *(const LAS bf16x8*)(sK + ((wid + i) * 16 + fr) * 136 + eb * 32 + fq * 8); acc = __builtin_amdgcn_mfma_f32_16x16x32_bf16(a, qf[eb], acc, 0, 0, 0); }
            sc[i] = acc;
        }
        const float c1 = 0.08838834764831845f * 1.4426950408889634f;
        const float slope2 = exp2f(-0.5f * (float)(h + 1)) * 1.4426950408889634f * (float)(1 << dl);
        float mx = -INFINITY;
        const int dlt = fr - 4 * fq; const float b0 = -slope2 * (float)(128 + dlt);
#pragma unroll
        for (int i = 0; i < 9; ++i) {
            const bool tile_ok = (qb > 0) || (wid + i >= 8);
#pragma unroll
            for (int j = 0; j < 4; ++j) {
                bool valid = tile_ok;
                if (i == 0) valid = valid && (dlt - j <= 0);
                if (i == 8) valid = valid && (dlt - j >= 0);
                const float sv = fmaf(sc[i][j], c1, b0 + slope2 * (float)(16 * i + j));
                const float s = valid ? sv : -INFINITY; sc[i][j] = s; mx = fmaxf(mx, s);
            }
        }
        mx = fmaxf(mx, __shfl_xor(mx, 16)); mx = fmaxf(mx, __shfl_xor(mx, 32));
        float lsum = 0.f;
#pragma unroll
        for (int i = 0; i < 9; ++i)
#pragma unroll
            for (int j = 0; j < 4; ++j) { const float pv = __builtin_amdgcn_exp2f(sc[i][j] - mx); sc[i][j] = pv; lsum += pv; }
        lsum += __shfl_xor(lsum, 16); lsum += __shfl_xor(lsum, 32);
#pragma unroll
        for (int ps = 0; ps < 8; ++ps) *(LAS u32x4*)(sV + (ps * 32 + r0) * 144 + ch * 8) = vv[ps];
        if (item_next >= 0) ATT_LOADK(item_next);
        LDS_BARRIER();
        f32x4 O[8];
#pragma unroll
        for (int et = 0; et < 8; ++et) O[et] = (f32x4){0.f, 0.f, 0.f, 0.f};
        const int q4 = (lane & 15) >> 2, p4 = lane & 3;
#pragma unroll
        for (int pr = 0; pr < 5; ++pr) {
            const int i0 = 2 * pr, i1 = (2 * pr + 1 < 9) ? 2 * pr + 1 : 2 * pr;
            u32x4 pbu;
            pbu[0] = pack2(sc[i0][0], sc[i0][1]); pbu[1] = pack2(sc[i0][2], sc[i0][3]);
            if (2 * pr + 1 < 9) { pbu[2] = pack2(sc[i1][0], sc[i1][1]); pbu[3] = pack2(sc[i1][2], sc[i1][3]); } else { pbu[2] = 0u; pbu[3] = 0u; }
            bf16x8 pb; { union { u32x4 u; bf16x8 s; } cv; cv.u = pbu; pb = cv.s; }
            const int row0 = (wid + i0) * 16 + 4 * fq + q4, row1 = (wid + i1) * 16 + 4 * fq + q4;
#pragma unroll
            for (int et = 0; et < 8; ++et) {
                const s16x4 lo = __builtin_amdgcn_ds_read_tr16_b64_v4i16((LAS s16x4*)(sV + row0 * 144 + et * 16 + 4 * p4));
                const s16x4 hi = __builtin_amdgcn_ds_read_tr16_b64_v4i16((LAS s16x4*)(sV + row1 * 144 + et * 16 + 4 * p4));
                const bf16x8 a = {lo[0], lo[1], lo[2], lo[3], hi[0], hi[1], hi[2], hi[3]};
                O[et] = __builtin_amdgcn_mfma_f32_16x16x32_bf16(a, pb, O[et], 0, 0, 0);
            }
        }
        const float inv = 1.f / lsum;
        bf16_t* od = ATTO + ((size_t)g * NTOK + tokq) * DM + h * 128 + 4 * fq;
#pragma unroll
        for (int et = 0; et < 8; ++et) { u32x2 pk = {pack2(O[et][0] * inv, O[et][1] * inv), pack2(O[et][2] * inv, O[et][3] * inv)}; *(u32x2*)(od + et * 16) = pk; }
        if (fq == 0) LSE[((size_t)g * NTOK + tokq) * 16 + h] = (mx + log2f(lsum)) * 0.6931471805599453f;
    }
    LDS_BARRIER();
#undef ATT_ITEM
#undef ATT_LOADK
#undef ATT_LOADV
#undef ATT_DECODE
}

__device__ __forceinline__ void attn_merge(const P& p) {
    unsigned char* ws = p.ws;
    const bf16_t* ATTO = (const bf16_t*)(ws + OFF_ATTO); const float* LSE = (const float*)(ws + OFF_LSE); bf16_t* OG = (bf16_t*)(ws + OFF_OG);
    const int gtid = blockIdx.x * 512 + threadIdx.x, nth = gridDim.x * 512;
    float nl0 = 0.f, nl1 = 0.f, nl2 = 0.f; u32x4 na = {0u, 0u, 0u, 0u}, nb = na, nc = na;
#define MERGE_LOAD(T_) do { const int _tok = (T_) >> 8, _ch = (T_) & 255, _h = _ch >> 4; \
        nl0 = LSE[(size_t)_tok * 16 + _h]; nl1 = LSE[((size_t)NTOK + _tok) * 16 + _h]; nl2 = LSE[((size_t)2 * NTOK + _tok) * 16 + _h]; \
        na = __builtin_nontemporal_load((const u32x4*)(ATTO + (size_t)_tok * DM + _ch * 8)); nb = __builtin_nontemporal_load((const u32x4*)(ATTO + ((size_t)NTOK + _tok) * DM + _ch * 8)); nc = __builtin_nontemporal_load((const u32x4*)(ATTO + ((size_t)2 * NTOK + _tok) * DM + _ch * 8)); } while (0)
    if (gtid < NTOK * 256) MERGE_LOAD(gtid);
    for (int T = gtid; T < NTOK * 256; T += nth) {
        const int tok = T >> 8, ch = T & 255;
        const float l0 = nl0, l1 = nl1, l2 = nl2; const u32x4 a = na, bq = nb, c = nc;
        if (T + nth < NTOK * 256) MERGE_LOAD(T + nth);
        const float m = fmaxf(l0, fmaxf(l1, l2)); float w0 = __expf(l0 - m), w1 = __expf(l1 - m), w2 = __expf(l2 - m); const float inv = __fdividef(1.f, w0 + w1 + w2); w0 *= inv; w1 *= inv; w2 *= inv;
        u32x4 pk;
#pragma unroll
        for (int j = 0; j < 4; ++j) pk[j] = pack2(w0 * bflo(a[j]) + w1 * bflo(bq[j]) + w2 * bflo(c[j]), w0 * bfhi(a[j]) + w1 * bfhi(bq[j]) + w2 * bfhi(c[j]));
        *(u32x4*)(OG + (size_t)tok * DM + ch * 8) = pk;
    }
#undef MERGE_LOAD
}

constexpr int N_PHASES = 17;
__device__ __forceinline__ void run_gemm_scale(const P& p, LAS unsigned char* lds, size_t offA, size_t offB, int N, int K, bf16_t* O, int ldo, const float* rstd, int nvalid, float* aout) {
    pg8::Gemm g{(const bf16_t*)(p.ws + offA), (const bf16_t*)(p.ws + offB), NTOK, N, K};
    pg8::StaticOrder S; S.init(NTOK, N, gridDim.x, blockIdx.x);
    EpiScaleBf16 E{O, ldo, rstd, nvalid, aout};
    pg8::gemm_phase<EpiScaleBf16, pg8::StaticOrder, true, true>(lds, g, S, E);
}
template <bool BASE_BF16> __device__ __forceinline__ void run_gemm_resid(const P& p, LAS unsigned char* lds, size_t offA, size_t offB, int K, const void* base, float* out) {
    pg8::Gemm g{(const bf16_t*)(p.ws + offA), (const bf16_t*)(p.ws + offB), NTOK, DM, K};
    pg8::StaticOrder S; S.init(NTOK, DM, gridDim.x, blockIdx.x);
    EpiResid<BASE_BF16> E{base, out};
    pg8::gemm_phase<EpiResid<BASE_BF16>, pg8::StaticOrder, true, true>(lds, g, S, E);
}
template <bool BASE_BF16> __device__ __forceinline__ void run_gemm_resid_norm(const P& p, LAS unsigned char* lds, size_t offA, size_t offB, int K, const void* base, float* sumsq) {
    pg8::Gemm g{(const bf16_t*)(p.ws + offA), (const bf16_t*)(p.ws + offB), NTOK, DM, K};
    pg8::StaticOrder S; S.init(NTOK, DM, gridDim.x, blockIdx.x);
    EpiResidNorm<BASE_BF16> E{base, (bf16_t*)(p.ws + OFF_XB), sumsq};
    pg8::gemm_phase<EpiResidNorm<BASE_BF16>, pg8::StaticOrder, true, true>(lds, g, S, E);
}
__global__ void __launch_bounds__(512, 2) mk_fwd(P p) {
    extern __shared__ __attribute__((aligned(16))) unsigned char lds_raw[];
    LAS unsigned char* lds = (LAS unsigned char*)lds_raw;
    unsigned char* ws = p.ws;
    float* RSTD = (float*)(ws + OFF_RSTD);
    float* H = p.out;
#ifndef PHMASK
#define PHMASK 0xFFFFF
#endif
    const int lo = p.ph_lo, hi = p.ph_hi;
    volatile LAS unsigned* xst = (volatile LAS unsigned*)(lds + LDS_BYTES - 16);
    if (threadIdx.x < 4) xst[threadIdx.x] = 0u;
    __syncthreads();
    XcdBarrier xb; xb.bar = (unsigned*)(ws + OFF_BAR); xb.x = 0; xb.st = xst;
    if (hi - lo > 1) xb = xcd_barrier_post((unsigned*)(ws + OFF_BAR), xst);
#define GRID_SEAM(k) do { if (p.ph_hi > 1000) { __syncthreads(); cg::this_grid().sync(); } xcd_barrier(xb); } while (0)
#ifndef PHDUP
#define PHDUP 0x0
#endif
#define PHASE(k, body) if (((PHMASK >> (k)) & 1) && lo <= (k) && (k) < hi) { if ((PHDUP >> (k)) & 1) { body; xcd_barrier(xb); } body; if ((k) + 1 < hi) GRID_SEAM(k); }
#ifdef PROBE_SYNCS
    if (hi - lo > 1) { for (int i = 0; i < PROBE_SYNCS; ++i) xcd_barrier(xb); }
#endif
    PHASE(0, phase_prologue(p, lds))
    PHASE(1, run_gemm_scale(p, lds, OFF_XB, OFF_WT_IN, 6144, DM, (bf16_t*)(ws + OFF_R1), 6144, RSTD, 6144, nullptr))
    PHASE(2, gla_prep(p, lds))
#ifdef PROBE_SCANMODE
    if (hi - lo > 1) { gla_scan(p, lds, PROBE_SCANMODE); xcd_barrier(xb); }
#endif
    PHASE(3, gla_scan(p, lds))
    PHASE(4, gla_gate(p))
    PHASE(5, run_gemm_resid_norm<false>(p, lds, OFF_OG, OFF_WT_GOUT, DM, p.x, RSTD + NTOK))
#ifdef PROBE_NULLGEMM
    if (hi - lo > 1) { pg8::Gemm g{(const bf16_t*)(p.ws + OFF_XB), (const bf16_t*)(p.ws + OFF_WT_UP0), NTOK, 2 * DFF, DM}; pg8::StaticOrder S; S.init(NTOK, 2 * DFF, gridDim.x, blockIdx.x); EpiNull E{(float*)(ws + OFF_AG)}; pg8::gemm_phase<EpiNull, pg8::StaticOrder, true, true>(lds, g, S, E); xcd_barrier(xb); }
#endif
    PHASE(6, run_gemm_scale(p, lds, OFF_XB, OFF_WT_UP0, 2 * DFF, DM, (bf16_t*)(ws + OFF_R1), 2 * DFF, RSTD + NTOK, 2 * DFF, nullptr))
    PHASE(7, convglu((const bf16_t*)(ws + OFF_R1), (bf16_t*)(ws + OFF_ACT), p.ffn_conv_w, p.ffn_conv_b))
    PHASE(8, run_gemm_resid_norm<true>(p, lds, OFF_ACT, OFF_WT_DN0, DFF, ws + OFF_XB, RSTD + 2 * NTOK))
    PHASE(9, run_gemm_scale(p, lds, OFF_XB, OFF_WT_KVQ, 10240, DM, (bf16_t*)(ws + OFF_R1), 10240, RSTD + 2 * NTOK, 10240, nullptr))
    PHASE(10, attn_phase(p, lds))
    PHASE(11, attn_merge(p))
    PHASE(12, run_gemm_resid_norm<true>(p, lds, OFF_OG, OFF_WT_AOUT, DM, ws + OFF_XB, RSTD + 3 * NTOK))
    PHASE(13, run_gemm_scale(p, lds, OFF_XB, OFF_WT_UP1, 2 * DFF, DM, (bf16_t*)(ws + OFF_R1), 2 * DFF, RSTD + 3 * NTOK, 2 * DFF, nullptr))
    PHASE(14, convglu((const bf16_t*)(ws + OFF_R1), (bf16_t*)(ws + OFF_ACT), p.ffn_conv_w + 3 * DFF, p.ffn_conv_b + DFF))
    PHASE(15, run_gemm_resid<true>(p, lds, OFF_ACT, OFF_WT_DN1, DFF, ws + OFF_XB, H))
    PHASE(16, final_norm_pass(H, p.final_norm))
}

extern "C" void kernel_launch(void* const* d_in, const int* in_sizes, int n_in, void* d_out, int out_size, void* d_ws, size_t ws_size, hipStream_t stream) {
    static int grid = 0;
    if (grid == 0) {
        if (n_in != 17 || out_size != NTOK * DM || ws_size < WS_END) { fprintf(stderr, "kernel_launch: unexpected shapes (n_in %d out %d ws %zu need %zu)\n", n_in, out_size, ws_size, (size_t)WS_END); grid = -1; return; }
        int dev = 0, cus = 0, per_cu = 0;
        hipGetDevice(&dev);
        hipDeviceGetAttribute(&cus, hipDeviceAttributeMultiprocessorCount, dev);
        if (hipFuncSetAttribute((const void*)mk_fwd, hipFuncAttributeMaxDynamicSharedMemorySize, LDS_BYTES) != hipSuccess) { fprintf(stderr, "kernel_launch: hipFuncSetAttribute failed\n"); grid = -1; return; }
        if (hipOccupancyMaxActiveBlocksPerMultiprocessor(&per_cu, (const void*)mk_fwd, 512, LDS_BYTES) != hipSuccess || per_cu < 1) { fprintf(stderr, "kernel_launch: occupancy query says %d\n", per_cu); per_cu = 1; }
        (void)hipGetLastError();
        grid = cus * 1;
        if (grid <= 0) grid = 256;
    }
    if (grid < 0) return;
    P p{};
    p.x = (const float*)d_in[0]; p.attn_norm = (const float*)d_in[1]; p.gla_w_in = (const float*)d_in[2]; p.gla_w_a2 = (const float*)d_in[3]; p.gla_b_a2 = (const float*)d_in[4];
    p.gla_head_norm = (const float*)d_in[5]; p.gla_w_out = (const float*)d_in[6]; p.kv_norm = (const float*)d_in[7]; p.w_kv = (const float*)d_in[8]; p.dsa_w_q = (const float*)d_in[9];
    p.dsa_w_out = (const float*)d_in[10]; p.ffn_norm = (const float*)d_in[11]; p.ffn_w_up = (const float*)d_in[12]; p.ffn_conv_w = (const float*)d_in[13]; p.ffn_conv_b = (const float*)d_in[14];
    p.ffn_w_down = (const float*)d_in[15]; p.final_norm = (const float*)d_in[16];
    p.out = (float*)d_out; p.ws = (unsigned char*)d_ws;
#if MK_ONE_LAUNCH
    if (hipMemsetAsync((char*)d_ws + OFF_BAR, 0, XCD_BAR_WORDS * 4, stream) != hipSuccess) { fprintf(stderr, "kernel_launch: memset of barrier words failed\n"); return; }
    p.ph_lo = 0; p.ph_hi = N_PHASES;
    void* args[] = {&p};
    hipError_t e = hipLaunchCooperativeKernel((const void*)mk_fwd, dim3(grid), dim3(512), args, LDS_BYTES, stream);
    if (e != hipSuccess) fprintf(stderr, "cooperative launch failed: %s (grid %d)\n", hipGetErrorString(e), grid);
#else
    for (int ph = 0; ph < N_PHASES; ++ph) {
        p.ph_lo = ph; p.ph_hi = ph + 1;
        hipLaunchKernelGGL(mk_fwd, dim3(grid), dim3(512), LDS_BYTES, stream, p);
    }
#endif
}
```

```cpp
#include <hip/hip_runtime.h>
#include <hip/hip_cooperative_groups.h>
#include <cstdio>
namespace cg = cooperative_groups;

#ifndef MK_ONE_LAUNCH
#define MK_ONE_LAUNCH 1
#endif

#define LAS __attribute__((address_space(3)))
typedef unsigned short bf16_t;
typedef short bf16x8 __attribute__((ext_vector_type(8)));
typedef short s16x4 __attribute__((ext_vector_type(4)));
typedef float f32x4 __attribute__((ext_vector_type(4)));
typedef unsigned u32x4 __attribute__((ext_vector_type(4)));
typedef unsigned u32x2 __attribute__((ext_vector_type(2)));

typedef __bf16 hwbf16x2 __attribute__((ext_vector_type(2)));
typedef float f32x2 __attribute__((ext_vector_type(2)));
__device__ __forceinline__ bf16_t f2bf(float f) { const __bf16 b = (__bf16)f; return __builtin_bit_cast(bf16_t, b); }
__device__ __forceinline__ float bf2f(bf16_t b) { return __uint_as_float(((unsigned)b) << 16); }
__device__ __forceinline__ unsigned pack2(float lo, float hi) { const f32x2 v = {lo, hi}; const hwbf16x2 b = __builtin_convertvector(v, hwbf16x2); return __builtin_bit_cast(unsigned, b); }
__device__ __forceinline__ float bflo(unsigned u) { return __uint_as_float(u << 16); }
__device__ __forceinline__ float bfhi(unsigned u) { return __uint_as_float(u & 0xFFFF0000u); }
#define LDS_BARRIER() do { asm volatile("s_waitcnt lgkmcnt(0)" ::: "memory"); __builtin_amdgcn_s_barrier(); asm volatile("" ::: "memory"); } while (0)
__device__ __forceinline__ float wave_sum(float v) {
#pragma unroll
    for (int o = 32; o > 0; o >>= 1) v += __shfl_xor(v, o);
    return v;
}

#define XB_TMO      128
#define XB_XCNT(j)  (256  + 64 * (j))
#define XB_XSUB(j)  (1280 + 64 * (j))
#define XB_XGEN(j)  (2304 + 64 * (j))
#define XB_TOP      3328
#define XB_TOPGEN   3392
#define XCD_BAR_WORDS 3456
#define XB_SPIN_CAP (1u << 18)
__device__ __forceinline__ unsigned xb_ld(unsigned* p)              { return __hip_atomic_load(p, __ATOMIC_RELAXED, __HIP_MEMORY_SCOPE_AGENT); }
__device__ __forceinline__ unsigned xb_add(unsigned* p, unsigned v) { return __hip_atomic_fetch_add(p, v, __ATOMIC_RELAXED, __HIP_MEMORY_SCOPE_AGENT); }
__device__ __forceinline__ unsigned xb_xcc_id() { return (unsigned)__builtin_amdgcn_s_getreg((3 << 11) | 20) & 0xFu; }
#define XB_SPIN(cond, bar) do { unsigned _sp = 0; while (cond) { __builtin_amdgcn_s_sleep(1); \
    if ((++_sp & 255u) == 0u) { if (xb_ld(&(bar)[XB_TMO])) break; if (_sp > XB_SPIN_CAP) { atomicAdd(&(bar)[XB_TMO], 1u); break; } } } } while (0)
struct XcdBarrier { unsigned* bar; unsigned x; volatile LAS unsigned* st; };
__device__ __forceinline__ XcdBarrier xcd_barrier_post(unsigned* bar, volatile LAS unsigned* st) {
    XcdBarrier b; b.bar = bar; b.x = xb_xcc_id(); b.st = st;
    if (threadIdx.x == 0) (void)xb_add(&bar[XB_XCNT(b.x)], 1u);
    return b;
}
__device__ __forceinline__ void xcd_barrier_complete(unsigned* bar, unsigned x, unsigned& nloc, unsigned& nx) {
    const unsigned G = gridDim.x * gridDim.y * gridDim.z;
    unsigned sum, cnt, mine, sp = 0u;
    for (;;) {
        sum = 0u; cnt = 0u; mine = 0u;
#pragma unroll
        for (unsigned j = 0; j < 16; ++j) { const unsigned c = xb_ld(&bar[XB_XCNT(j)]); sum += c; cnt += (c > 0u) ? 1u : 0u; mine = (j == x) ? c : mine; }
        if (sum == G) break;
        __builtin_amdgcn_s_sleep(1);
        if ((++sp & 255u) == 0u) { if (xb_ld(&bar[XB_TMO])) break; if (sp > XB_SPIN_CAP) { atomicAdd(&bar[XB_TMO], 1u); break; } }
    }
    nloc = mine > 0u ? mine : 1u; nx = cnt > 0u ? cnt : 1u;
}
__device__ __forceinline__ void xcd_barrier(const XcdBarrier& b) {
    asm volatile("s_waitcnt vmcnt(0)" ::: "memory");
    __syncthreads();
    if (threadIdx.x == 0) {
        unsigned* bar = b.bar;
        __builtin_amdgcn_s_waitcnt(0);
        unsigned nloc = b.st[0], nx = b.st[1];
        if (nloc == 0u) { xcd_barrier_complete(bar, b.x, nloc, nx); b.st[0] = nloc; b.st[1] = nx; }
        const unsigned old = xb_add(&bar[XB_XSUB(b.x)], 1u);
        const unsigned gen = old / nloc;
        if (old + 1u == (gen + 1u) * nloc) {
            __builtin_amdgcn_fence(__ATOMIC_RELEASE, "agent");
            asm volatile("s_waitcnt vmcnt(0)" ::: "memory");
            const unsigned og = xb_add(&bar[XB_TOP], 1u);
            const unsigned tg = og / nx;
            if (og + 1u == (tg + 1u) * nx) xb_add(&bar[XB_TOPGEN], 1u);
            else XB_SPIN(xb_ld(&bar[XB_TOPGEN]) == tg, bar);
            __builtin_amdgcn_fence(__ATOMIC_ACQUIRE, "agent");
            xb_add(&bar[XB_XGEN(b.x)], 1u);
            asm volatile("s_waitcnt vmcnt(0)" ::: "memory");
        } else {
            XB_SPIN(xb_ld(&bar[XB_XGEN(b.x)]) == gen, bar);
            __builtin_amdgcn_fence(__ATOMIC_ACQUIRE, "agent");
            asm volatile("s_waitcnt vmcnt(0)" ::: "memory");
        }
    }
    __syncthreads();
}

namespace pg8 {
constexpr int BM = 256, BK = 64, HALF = 128, HTB = HALF * BK * 2, STAGE_BYTES = 8 * HTB, NXCD = 8, WGM = 8;
__device__ __forceinline__ int lds_byte(int r, int c) { const int st = (r >> 4) * 2 + (c >> 5), rr = r & 15, cc = c & 31, ob = rr * 64 + cc * 2; return st * 1024 + (ob ^ (((ob >> 9) & 1) << 5)); }
__device__ __forceinline__ void stage_rc(int b, int& R, int& C) { const int st = b / 1024, sb = b % 1024, swz = sb ^ (((sb >> 9) & 1) << 5); R = (st >> 1) * 16 + swz / 64; C = (st & 1) * 32 + (swz % 64) / 2; }
__device__ __forceinline__ int perm32(int rho) { const int n = rho >> 4, i = rho & 15; return 8 * (i >> 2) + 4 * n + (i & 3); }
struct Unit { int pm, pn; };
struct Gemm { const bf16_t* A; const bf16_t* Bt; int M, N, K; };
struct StaticOrder {
    int nM, nN, nwg, G, c;
    __device__ void init(int M, int N, int G_, int c_) { nM = M / BM; nN = N / BM; nwg = nM * nN; G = G_; c = c_; }
    __device__ bool next(int i, Unit& u) const {
        const long L = (long)i * G + c; if (L >= nwg) return false;
        int wgid = (int)L; { const int q = nwg / NXCD, r = nwg % NXCD, xcd = wgid % NXCD, off = wgid / NXCD; wgid = (xcd < r ? xcd * (q + 1) : r * (q + 1) + (xcd - r) * q) + off; }
        const int nig = WGM * nN, gid = wgid / nig, fm = gid * WGM, gsz = (nM - fm) < WGM ? (nM - fm) : WGM;
        u.pm = fm + ((wgid % nig) % gsz); u.pn = (wgid % nig) / gsz; return true;
    }
    __device__ __forceinline__ void a_ready(const Unit&) const {}
    __device__ __forceinline__ void done(const Unit&) const {}
};

template <class Epi, class Sched, bool ALIGN_EPI = false, bool SP2 = false>
__device__ __forceinline__ void gemm_phase(LAS unsigned char* lds, const Gemm g, const Sched& S, const Epi& E) {
    const int tid = threadIdx.x, wid = __builtin_amdgcn_readfirstlane(tid >> 6), lane = tid & 63, wr = wid >> 2, wc = wid & 3, fr = lane & 15, fq = lane >> 4;
    const int K = g.K, nt = K / BK;
    unsigned voffA[2], voffB[2];
#pragma unroll
    for (int i = 0; i < 2; ++i) { int R, C; stage_rc(tid * 16 + i * 8192, R, C); const int Rb = Epi::PERM ? ((R & ~31) + perm32(R & 31)) : R;
        voffA[i] = (unsigned)(R * K + C) * 2u; voffB[i] = (unsigned)(Rb * K + C) * 2u; }
    const size_t kstep = (size_t)(BK * 2);
    const size_t hstep = (size_t)HALF * K * 2;
    const size_t tstep = 2 * hstep;
    const unsigned ldsw = (unsigned)wid * 1024u;
    const int aoff = lds_byte(wr * 64 + fr, fq * 8), boff = lds_byte(wc * 32 + fr, fq * 8);
#define PG8_SA(b, h) (((b) * 2 + (h)) * HTB)
#define PG8_SB(b, h) ((4 + (b) * 2 + (h)) * HTB)
#define PG8_STAGE(bufoff, gbase, voff) do { _Pragma("unroll") for (int _i = 0; _i < 2; ++_i) \
        __builtin_amdgcn_global_load_lds((const unsigned*)((const char*)(gbase) + (voff)[_i]), (LAS unsigned*)(lds + (bufoff) + ldsw + _i * 8192), 16, 0, 0); } while (0)
#define PG8_LDA(dst, b, h) do { _Pragma("unroll") for (int m = 0; m < 4; ++m) _Pragma("unroll") for (int k = 0; k < 2; ++k) dst[m][k] = *(const LAS bf16x8*)(lds + PG8_SA(b, h) + aoff + m * 2048 + k * 1024); } while (0)
#define PG8_LDB(dst, b, h) do { _Pragma("unroll") for (int n = 0; n < 2; ++n) _Pragma("unroll") for (int k = 0; k < 2; ++k) dst[n][k] = *(const LAS bf16x8*)(lds + PG8_SB(b, h) + boff + n * 2048 + k * 1024); } while (0)
#define PG8_MMA(ai, bj, At, Bt) do { __builtin_amdgcn_s_setprio(1); _Pragma("unroll") for (int m = 0; m < 4; ++m) _Pragma("unroll") for (int n = 0; n < 2; ++n) _Pragma("unroll") for (int k = 0; k < 2; ++k) \
        acc[ai][bj][m][n] = __builtin_amdgcn_mfma_f32_16x16x32_bf16(Bt[n][k], At[m][k], acc[ai][bj][m][n], 0, 0, 0); __builtin_amdgcn_s_setprio(0); } while (0)
#define PG8_WAIT_V(n) asm volatile("s_waitcnt vmcnt(" #n ")" ::: "memory")
#define PG8_WAIT_L(n) asm volatile("s_waitcnt lgkmcnt(" #n ")" ::: "memory")
#define PG8_BAR __builtin_amdgcn_s_barrier()
#define PG8_SCHED __builtin_amdgcn_sched_barrier(0)
    Unit cur, nxt; int ui = 0;
    if (!S.next(0, cur)) return;
    f32x4 acc[2][2][4][2];
#pragma unroll
    for (int a = 0; a < 2; ++a)
#pragma unroll
        for (int b = 0; b < 2; ++b)
#pragma unroll
            for (int m = 0; m < 4; ++m)
#pragma unroll
                for (int n = 0; n < 2; ++n) acc[a][b][m][n] = (f32x4){0.f, 0.f, 0.f, 0.f};
    bf16x8 At[4][2], B0[2][2], B1[2][2];
    const char* cA = (const char*)g.A + (size_t)cur.pm * tstep; const char* cB = (const char*)g.Bt + (size_t)cur.pn * tstep;
    S.a_ready(cur);
    if constexpr (SP2) {
        PG8_STAGE(PG8_SB(0, 0), cB, voffB); PG8_STAGE(PG8_SB(0, 1), cB + hstep, voffB); PG8_STAGE(PG8_SA(0, 0), cA, voffA); PG8_STAGE(PG8_SA(0, 1), cA + hstep, voffA);
        if (wr == 1) PG8_BAR;
        PG8_WAIT_V(2); PG8_BAR;
        PG8_STAGE(PG8_SB(1, 0), cB + kstep, voffB); PG8_STAGE(PG8_SA(1, 0), cA + kstep, voffA); PG8_STAGE(PG8_SB(1, 1), cB + hstep + kstep, voffB);
        PG8_WAIT_V(6); PG8_BAR;
    } else {
        PG8_STAGE(PG8_SB(0, 0), cB, voffB); PG8_STAGE(PG8_SA(0, 0), cA, voffA); PG8_STAGE(PG8_SB(0, 1), cB + hstep, voffB); PG8_STAGE(PG8_SA(0, 1), cA + hstep, voffA);
        if (wr == 1) PG8_BAR;
        PG8_WAIT_V(4); PG8_BAR;
        PG8_STAGE(PG8_SB(1, 0), cB + kstep, voffB); PG8_STAGE(PG8_SA(1, 0), cA + kstep, voffA); PG8_STAGE(PG8_SB(1, 1), cB + hstep + kstep, voffB);
        PG8_WAIT_V(6); PG8_BAR;
    }
    for (;;) {
        const bool has_next = S.next(ui + 1, nxt);
        const char* nA = has_next ? (const char*)g.A + (size_t)nxt.pm * tstep : cA; const char* nB = has_next ? (const char*)g.Bt + (size_t)nxt.pn * tstep : cB;
        for (int t = 0; t < nt; t += 2) {
            const bool last = (t == nt - 2);
            const char* a1 = cA + (size_t)(t + 1) * kstep;
            const char* a2 = last ? nA : cA + (size_t)(t + 2) * kstep; const char* b2 = last ? nB : cB + (size_t)(t + 2) * kstep;
            const char* a3 = a2 + kstep; const char* b3 = b2 + kstep;
            if (last && has_next) S.a_ready(nxt);
            if constexpr (SP2) {
            PG8_LDB(B0, 0, 0); PG8_LDB(B1, 0, 1); PG8_SCHED; PG8_LDA(At, 0, 0); PG8_STAGE(PG8_SA(1, 1), a1 + hstep, voffA);
            PG8_WAIT_V(8); PG8_WAIT_L(0); PG8_BAR; PG8_MMA(0, 0, At, B0); PG8_MMA(0, 1, At, B1); PG8_BAR; PG8_SCHED;
            PG8_LDA(At, 0, 1); PG8_STAGE(PG8_SB(0, 0), b2, voffB); PG8_STAGE(PG8_SB(0, 1), b2 + hstep, voffB); PG8_STAGE(PG8_SA(0, 0), a2, voffA);
            PG8_WAIT_V(8); PG8_WAIT_L(0); PG8_BAR; PG8_MMA(1, 0, At, B0); PG8_MMA(1, 1, At, B1); PG8_BAR; PG8_SCHED;
            PG8_LDB(B0, 1, 0); PG8_LDB(B1, 1, 1); PG8_SCHED; PG8_LDA(At, 1, 0); PG8_STAGE(PG8_SA(0, 1), a2 + hstep, voffA);
            PG8_WAIT_V(8); PG8_WAIT_L(0); PG8_BAR; PG8_MMA(0, 0, At, B0); PG8_MMA(0, 1, At, B1); PG8_BAR; PG8_SCHED;
            PG8_LDA(At, 1, 1); PG8_STAGE(PG8_SB(1, 0), b3, voffB); PG8_STAGE(PG8_SB(1, 1), b3 + hstep, voffB); PG8_STAGE(PG8_SA(1, 0), a3, voffA);
            PG8_WAIT_V(8); PG8_WAIT_L(0); PG8_BAR; PG8_MMA(1, 0, At, B0); PG8_MMA(1, 1, At, B1); PG8_BAR; PG8_SCHED;
            } else {
            PG8_LDB(B0, 0, 0); PG8_SCHED; PG8_LDA(At, 0, 0); PG8_STAGE(PG8_SA(1, 1), a1 + hstep, voffA);
            PG8_WAIT_L(8); PG8_BAR; PG8_WAIT_L(0); PG8_MMA(0, 0, At, B0); PG8_BAR; PG8_SCHED;
            PG8_LDB(B1, 0, 1); PG8_STAGE(PG8_SB(0, 0), b2, voffB);
            PG8_BAR; PG8_WAIT_L(0); PG8_MMA(0, 1, At, B1); PG8_BAR;
            PG8_LDA(At, 0, 1); PG8_STAGE(PG8_SA(0, 0), a2, voffA);
            PG8_BAR; PG8_WAIT_L(0); PG8_MMA(1, 0, At, B0); PG8_BAR; PG8_SCHED;
            PG8_STAGE(PG8_SB(0, 1), b2 + hstep, voffB);
            PG8_WAIT_V(6); PG8_BAR; PG8_MMA(1, 1, At, B1); PG8_BAR;
            PG8_LDB(B0, 1, 0); PG8_SCHED; PG8_LDA(At, 1, 0); PG8_STAGE(PG8_SA(0, 1), a2 + hstep, voffA);
            PG8_WAIT_L(8); PG8_BAR; PG8_WAIT_L(0); PG8_MMA(0, 0, At, B0); PG8_BAR; PG8_SCHED;
            PG8_LDB(B1, 1, 1); PG8_STAGE(PG8_SB(1, 0), b3, voffB);
            PG8_BAR; PG8_WAIT_L(0); PG8_MMA(0, 1, At, B1); PG8_BAR;
            PG8_LDA(At, 1, 1); PG8_STAGE(PG8_SA(1, 0), a3, voffA);
            PG8_BAR; PG8_WAIT_L(0); PG8_MMA(1, 0, At, B0); PG8_BAR; PG8_SCHED;
            PG8_STAGE(PG8_SB(1, 1), b3 + hstep, voffB);
            PG8_WAIT_V(6); PG8_BAR; PG8_MMA(1, 1, At, B1); PG8_BAR;
            }
        }
        if constexpr (ALIGN_EPI) { if (wr == 0) PG8_BAR; }
        if constexpr (!Epi::AFTER_DRAIN) { E(acc, cur, wr, wc, fr, fq); S.done(cur); }
        if (!has_next) break;
#pragma unroll
        for (int a = 0; a < 2; ++a)
#pragma unroll
            for (int b = 0; b < 2; ++b)
#pragma unroll
                for (int m = 0; m < 4; ++m)
#pragma unroll
                    for (int n = 0; n < 2; ++n) acc[a][b][m][n] = (f32x4){0.f, 0.f, 0.f, 0.f};
        cur = nxt; cA = nA; cB = nB; ++ui;
        if constexpr (ALIGN_EPI) { if (wr == 1) PG8_BAR; }
    }
    PG8_WAIT_V(0);
    if constexpr (!ALIGN_EPI) { if (wr == 0) PG8_BAR; }
    PG8_BAR;
    if constexpr (Epi::AFTER_DRAIN) { E.fused(acc, cur, wr, wc, fr, fq, lds, wid, lane); S.done(cur); }
#undef PG8_SA
#undef PG8_SB
#undef PG8_STAGE
#undef PG8_LDA
#undef PG8_LDB
#undef PG8_MMA
#undef PG8_WAIT_V
#undef PG8_WAIT_L
#undef PG8_BAR
#undef PG8_SCHED
}
}

struct EpiScaleBf16 {
    static constexpr bool PERM = true, AFTER_DRAIN = false;
    bf16_t* O; int ldo; const float* rstd; int nvalid; float* aout;
    __device__ __forceinline__ void operator()(const f32x4 (&acc)[2][2][4][2], const pg8::Unit& u, int wr, int wc, int fr, int fq) const {
        const int row0 = u.pm * 256 + wr * 64 + fr, colb = u.pn * 256 + wc * 32 + 8 * fq;
#pragma unroll
        for (int ai = 0; ai < 2; ++ai)
#pragma unroll
            for (int m = 0; m < 4; ++m) {
                const int r = row0 + ai * 128 + m * 16; const float s = rsqrtf(rstd[r] * (1.f / 2048.f) + 1e-6f);
#pragma unroll
                for (int bj = 0; bj < 2; ++bj) {
                    const int c = colb + bj * 128; const f32x4 v0 = acc[ai][bj][m][0] * s, v1 = acc[ai][bj][m][1] * s;
                    if (c < nvalid) { u32x4 pk = {pack2(v0[0], v0[1]), pack2(v0[2], v0[3]), pack2(v1[0], v1[1]), pack2(v1[2], v1[3])}; *(u32x4*)(O + (size_t)r * ldo + c) = pk; }
                    else if (aout && c < nvalid + 16) { float* ap = aout + (size_t)r * 16 + (c - nvalid); *(f32x4*)ap = v0; *(f32x4*)(ap + 4) = v1; }
                }
            }
    }
};
struct EpiNull { static constexpr bool PERM = true, AFTER_DRAIN = false; float* sink;
    __device__ __forceinline__ void operator()(const f32x4 (&acc)[2][2][4][2], const pg8::Unit& u, int wr, int wc, int fr, int fq) const {
        float t = 0.f;
#pragma unroll
        for (int ai = 0; ai < 2; ++ai)
#pragma unroll
            for (int bj = 0; bj < 2; ++bj)
#pragma unroll
                for (int m = 0; m < 4; ++m)
#pragma unroll
                    for (int n = 0; n < 2; ++n) t += acc[ai][bj][m][n][0] + acc[ai][bj][m][n][1] + acc[ai][bj][m][n][2] + acc[ai][bj][m][n][3];
        if (t == 1.2345e30f) sink[0] = t;
    } };
template <bool BASE_BF16> struct EpiResid {
    static constexpr bool PERM = false, AFTER_DRAIN = false;
    const void* base; float* out;
    __device__ __forceinline__ void operator()(const f32x4 (&acc)[2][2][4][2], const pg8::Unit& u, int wr, int wc, int fr, int fq) const {
        const int row0 = u.pm * 256 + wr * 64 + fr, col0 = u.pn * 256 + wc * 32 + 4 * fq;
#pragma unroll
        for (int ai = 0; ai < 2; ++ai)
#pragma unroll
            for (int mp = 0; mp < 2; ++mp) {
                f32x4 bv[2][2][2];
#pragma unroll
                for (int mm = 0; mm < 2; ++mm)
#pragma unroll
                    for (int bj = 0; bj < 2; ++bj)
#pragma unroll
                        for (int n = 0; n < 2; ++n) { const size_t idx = (size_t)(row0 + ai * 128 + (mp * 2 + mm) * 16) * 2048 + col0 + bj * 128 + n * 16;
                            if (BASE_BF16) { const u32x2 t = *(const u32x2*)((const bf16_t*)base + idx); bv[mm][bj][n] = (f32x4){bflo(t[0]), bfhi(t[0]), bflo(t[1]), bfhi(t[1])}; }
                            else bv[mm][bj][n] = *(const f32x4*)((const float*)base + idx); }
#pragma unroll
                for (int mm = 0; mm < 2; ++mm)
#pragma unroll
                    for (int bj = 0; bj < 2; ++bj)
#pragma unroll
                        for (int n = 0; n < 2; ++n) *(f32x4*)(out + (size_t)(row0 + ai * 128 + (mp * 2 + mm) * 16) * 2048 + col0 + bj * 128 + n * 16) = bv[mm][bj][n] + acc[ai][bj][mp * 2 + mm][n];
            }
    }
};
template <bool BASE_BF16> struct EpiResidNorm {
    static constexpr bool PERM = false, AFTER_DRAIN = false;
    const void* base; bf16_t* xb; float* sumsq;
    __device__ __forceinline__ void operator()(const f32x4 (&acc)[2][2][4][2], const pg8::Unit& u, int wr, int wc, int fr, int fq) const {
        const int row0 = u.pm * 256 + wr * 64 + fr, col0 = u.pn * 256 + wc * 32 + 4 * fq;
#pragma unroll
        for (int ai = 0; ai < 2; ++ai)
#pragma unroll
            for (int mp = 0; mp < 2; ++mp) {
                f32x4 bv[2][2][2];
#pragma unroll
                for (int mm = 0; mm < 2; ++mm)
#pragma unroll
                    for (int bj = 0; bj < 2; ++bj)
#pragma unroll
                        for (int n = 0; n < 2; ++n) { const size_t idx = (size_t)(row0 + ai * 128 + (mp * 2 + mm) * 16) * 2048 + col0 + bj * 128 + n * 16;
                            if (BASE_BF16) { const u32x2 t = *(const u32x2*)((const bf16_t*)base + idx); bv[mm][bj][n] = (f32x4){bflo(t[0]), bfhi(t[0]), bflo(t[1]), bfhi(t[1])}; }
                            else bv[mm][bj][n] = *(const f32x4*)((const float*)base + idx); }
#pragma unroll
                for (int mm = 0; mm < 2; ++mm) {
                    const int r = row0 + ai * 128 + (mp * 2 + mm) * 16; float ss = 0.f;
#pragma unroll
                    for (int bj = 0; bj < 2; ++bj)
#pragma unroll
                        for (int n = 0; n < 2; ++n) { const size_t idx = (size_t)r * 2048 + col0 + bj * 128 + n * 16; const f32x4 v = bv[mm][bj][n] + acc[ai][bj][mp * 2 + mm][n];
                            u32x2 pk = {pack2(v[0], v[1]), pack2(v[2], v[3])}; *(u32x2*)(xb + idx) = pk; ss += v[0] * v[0] + v[1] * v[1] + v[2] * v[2] + v[3] * v[3]; }
                    ss += __shfl_xor(ss, 16); ss += __shfl_xor(ss, 32);
                    if (fq == 0) __hip_atomic_fetch_add(sumsq + r, ss, __ATOMIC_RELAXED, __HIP_MEMORY_SCOPE_AGENT);
                }
            }
    }
};

constexpr int NTOK = 8192, DM = 2048, SEQ = 4096, DFF = 5632, NIN = 6160, NINP = 6400;
constexpr int LDS_BYTES = 147456;
constexpr size_t al256(size_t x) { return (x + 255) & ~(size_t)255; }
constexpr size_t OFF_WT_IN = 0;
constexpr size_t OFF_WT_GOUT = OFF_WT_IN + al256((size_t)NINP * DM * 2);
constexpr size_t OFF_WT_UP0 = OFF_WT_GOUT + al256((size_t)DM * DM * 2);
constexpr size_t OFF_WT_UP1 = OFF_WT_UP0 + al256((size_t)2 * DFF * DM * 2);
constexpr size_t OFF_WT_DN0 = OFF_WT_UP1 + al256((size_t)2 * DFF * DM * 2);
constexpr size_t OFF_WT_DN1 = OFF_WT_DN0 + al256((size_t)DM * DFF * 2);
constexpr size_t OFF_WT_KVQ = OFF_WT_DN1 + al256((size_t)DM * DFF * 2);
constexpr size_t OFF_WT_AOUT = OFF_WT_KVQ + al256((size_t)10240 * DM * 2);
constexpr size_t OFF_XB = OFF_WT_AOUT + al256((size_t)DM * DM * 2);
constexpr size_t OFF_OG = OFF_XB + al256((size_t)NTOK * DM * 2);
constexpr size_t OFF_RSTD = OFF_OG + al256((size_t)NTOK * DM * 2);
constexpr size_t OFF_AG = OFF_RSTD + al256((size_t)4 * NTOK * 4);
constexpr size_t OFF_DEC = OFF_AG + al256((size_t)NTOK * 16 * 4);
constexpr size_t OFF_LSE = OFF_DEC + al256((size_t)512 * 256 * 4);
constexpr size_t OFF_BAR = OFF_LSE + al256((size_t)3 * NTOK * 16 * 4);
constexpr size_t OFF_R1 = OFF_BAR + al256((size_t)XCD_BAR_WORDS * 4);
constexpr size_t OFF_R2 = OFF_R1 + al256((size_t)NTOK * 2 * DFF * 2);
constexpr size_t OFF_OGLA = OFF_R2;
constexpr size_t OFF_QD = OFF_OGLA + al256((size_t)NTOK * DM * 4);
constexpr size_t OFF_KTE = OFF_QD + al256((size_t)NTOK * 1024 * 2);
constexpr size_t OFF_PSC = OFF_KTE + al256((size_t)NTOK * 1024 * 2);
constexpr size_t R2_GLA_END = OFF_PSC + al256((size_t)512 * 4096 * 2);
constexpr size_t OFF_ACT = OFF_R2;
constexpr size_t OFF_ATTO = OFF_R2;
constexpr size_t R2_SIZE = (R2_GLA_END - OFF_R2) > (size_t)3 * NTOK * DM * 2 ? (R2_GLA_END - OFF_R2) : (size_t)3 * NTOK * DM * 2;
constexpr size_t WS_END = OFF_R2 + R2_SIZE;

struct P {
    const float* x; const float* attn_norm; const float* gla_w_in; const float* gla_w_a2; const float* gla_b_a2; const float* gla_head_norm; const float* gla_w_out;
    const float* kv_norm; const float* w_kv; const float* dsa_w_q; const float* dsa_w_out; const float* ffn_norm; const float* ffn_w_up; const float* ffn_conv_w;
    const float* ffn_conv_b; const float* ffn_w_down; const float* final_norm;
    float* out; unsigned char* ws; int ph_lo, ph_hi;
};

__device__ __forceinline__ void convert_job(const float* __restrict__ W, int ldw, int K, int N, const float* __restrict__ gain, bf16_t* __restrict__ Wt, int& g, int& base, LAS unsigned char* lds) {
    const int nkb = K / 128, ntiles = (N / 64) * nkb;
    const int tid = threadIdx.x;
    LAS bf16_t* T = (LAS bf16_t*)lds;
    const int n4 = tid & 15, kr = tid >> 4;
    while (g < base + ntiles) {
        const int t = g - base; const int nb = t / nkb, kb = t - nb * nkb;
        const int n0 = nb * 64, k0 = kb * 128;
        f32x4 v[4]; float gn[4];
#pragma unroll
        for (int q = 0; q < 4; ++q) { const int k = k0 + kr + 32 * q; v[q] = __builtin_nontemporal_load((const f32x4*)(W + (size_t)k * ldw + n0 + n4 * 4)); gn[q] = gain ? gain[k] : 1.f; }
#pragma unroll
        for (int q = 0; q < 4; ++q)
#pragma unroll
            for (int j = 0; j < 4; ++j) T[(n4 * 4 + j) * 136 + kr + 32 * q] = f2bf(v[q][j] * gn[q]);
        __syncthreads();
#pragma unroll
        for (int q = 0; q < 2; ++q) { const int c = tid + 512 * q; const int n = c >> 4, kc = c & 15; const u32x4 dd = *(const LAS u32x4*)(T + n * 136 + kc * 8); __builtin_nontemporal_store(dd, (u32x4*)(Wt + (size_t)(n0 + n) * K + k0 + kc * 8)); }
        __syncthreads();
        g += gridDim.x;
    }
    base += ntiles;
}

__device__ __forceinline__ void norm_pass(const float* __restrict__ src, bf16_t* __restrict__ dst, float* __restrict__ rstd) {
    const int lane = threadIdx.x & 63, wave = threadIdx.x >> 6;
    const int row0 = blockIdx.x * 8 + wave, rstep = gridDim.x * 8;
    f32x4 nv[8];
#pragma unroll
    for (int i = 0; i < 8; ++i) nv[i] = (f32x4){0.f, 0.f, 0.f, 0.f};
    if (row0 < NTOK) {
#pragma unroll
        for (int i = 0; i < 8; ++i) nv[i] = __builtin_nontemporal_load((const f32x4*)(src + (size_t)row0 * DM + (i * 64 + lane) * 4));
    }
    for (int row = row0; row < NTOK; row += rstep) {
        f32x4 v[8]; float ss = 0.f;
#pragma unroll
        for (int i = 0; i < 8; ++i) { v[i] = nv[i]; ss += v[i][0] * v[i][0] + v[i][1] * v[i][1] + v[i][2] * v[i][2] + v[i][3] * v[i][3]; }
        if (row + rstep < NTOK) {
#pragma unroll
            for (int i = 0; i < 8; ++i) nv[i] = __builtin_nontemporal_load((const f32x4*)(src + (size_t)(row + rstep) * DM + (i * 64 + lane) * 4));
        }
        ss = wave_sum(ss);
        if (lane == 0) rstd[row] = ss;
#pragma unroll
        for (int i = 0; i < 8; ++i) { u32x2 pk = {pack2(v[i][0], v[i][1]), pack2(v[i][2], v[i][3])}; __builtin_nontemporal_store(pk, (u32x2*)(dst + (size_t)row * DM + (i * 64 + lane) * 4)); }
    }
}

__device__ __forceinline__ void final_norm_pass(float* h, const float* __restrict__ gain) {
    const int lane = threadIdx.x & 63, wave = threadIdx.x >> 6;
    const int row0 = blockIdx.x * 8 + wave, rstep = gridDim.x * 8;
    f32x4 gg[8], nv[8];
#pragma unroll
    for (int i = 0; i < 8; ++i) { gg[i] = *(const f32x4*)(gain + (i * 64 + lane) * 4); nv[i] = (f32x4){0.f, 0.f, 0.f, 0.f}; }
    if (row0 < NTOK) {
#pragma unroll
        for (int i = 0; i < 8; ++i) nv[i] = __builtin_nontemporal_load((const f32x4*)(h + (size_t)row0 * DM + (i * 64 + lane) * 4));
    }
    for (int row = row0; row < NTOK; row += rstep) {
        float* s = h + (size_t)row * DM; f32x4 v[8]; float ss = 0.f;
#pragma unroll
        for (int i = 0; i < 8; ++i) { v[i] = nv[i]; ss += v[i][0] * v[i][0] + v[i][1] * v[i][1] + v[i][2] * v[i][2] + v[i][3] * v[i][3]; }
        if (row + rstep < NTOK) {
#pragma unroll
            for (int i = 0; i < 8; ++i) nv[i] = __builtin_nontemporal_load((const f32x4*)(h + (size_t)(row + rstep) * DM + (i * 64 + lane) * 4));
        }
        ss = wave_sum(ss);
        const float rs = rsqrtf(ss * (1.f / DM) + 1e-6f);
#pragma unroll
        for (int i = 0; i < 8; ++i) __builtin_nontemporal_store(v[i] * rs * gg[i], (f32x4*)(s + (i * 64 + lane) * 4));
    }
}

constexpr int CONV_BATCHES = (2 * (512 + 2816 + 1408) + 1024 + 1536) / 4;
__device__ __forceinline__ bool conv_locate(const P& p, int g, const float*& W, int& ldw, int& K, const float*& gain, bf16_t*& Wt, int& t) {
    unsigned char* ws = p.ws; int base = 0;
#define CJ(Wp, LDW, KK, NN, GP, DST) { const int nt_ = ((NN) / 128) * ((KK) / 256); if (g < base + nt_) { W = (Wp); ldw = (LDW); K = (KK); gain = (GP); Wt = (bf16_t*)(DST); t = g - base; return true; } base += nt_; }
    CJ(p.gla_w_out, DM, DM, DM, nullptr, ws + OFF_WT_GOUT)
    CJ(p.ffn_w_up, 2 * DFF, DM, 2 * DFF, p.ffn_norm, ws + OFF_WT_UP0)
    CJ(p.ffn_w_down, DM, DFF, DM, nullptr, ws + OFF_WT_DN0)
    CJ(p.w_kv, 4096, DM, 4096, p.kv_norm, ws + OFF_WT_KVQ)
    CJ(p.dsa_w_q, 6144, DM, 6144, p.attn_norm + DM, ws + OFF_WT_KVQ + (size_t)4096 * DM * 2)
    CJ(p.dsa_w_out, DM, DM, DM, nullptr, ws + OFF_WT_AOUT)
    CJ(p.ffn_w_up + (size_t)DM * 2 * DFF, 2 * DFF, DM, 2 * DFF, p.ffn_norm + DM, ws + OFF_WT_UP1)
    CJ(p.ffn_w_down + (size_t)DFF * DM, DM, DFF, DM, nullptr, ws + OFF_WT_DN1)
#undef CJ
    return false;
}

__device__ __forceinline__ int conv_nb2(const P& p, const float* W) {
    if (W == p.ffn_w_up || W == p.ffn_w_up + (size_t)DM * 2 * DFF) return 2 * DFF / 128;
    if (W == p.w_kv) return 4096 / 128;
    if (W == p.dsa_w_q) return 6144 / 128;
    return DM / 128;
}

__device__ __forceinline__ void phase_prologue(const P& p, LAS unsigned char* lds) {
    unsigned char* ws = p.ws;
    norm_pass(p.x, (bf16_t*)(ws + OFF_XB), (float*)(ws + OFF_RSTD));
    {
        bf16_t* wt = (bf16_t*)(ws + OFF_WT_IN);
        for (int i = blockIdx.x * 512 + threadIdx.x; i < 16 * DM; i += gridDim.x * 512) {
            const int j = i >> 11, k = i & 2047; const float v = p.gla_w_in[(size_t)k * NIN + 6144 + j] * p.attn_norm[k];
            wt[(size_t)(6144 + j) * DM + k] = f2bf(v);
        }
        float* ssz = (float*)(ws + OFF_RSTD) + NTOK;
        for (int i = blockIdx.x * 512 + threadIdx.x; i < 3 * NTOK; i += gridDim.x * 512) ssz[i] = 0.f;
    }
    int g = blockIdx.x, base = 0;
    convert_job(p.gla_w_in, NIN, DM, 6144, p.attn_norm, (bf16_t*)(ws + OFF_WT_IN), g, base, lds);
}

__device__ __forceinline__ void gla_prep(const P& p, LAS unsigned char* lds) {
    unsigned char* ws = p.ws;
    const bf16_t* PROJ = (const bf16_t*)(ws + OFF_R1); const bf16_t* XB = (const bf16_t*)(ws + OFF_XB); const bf16_t* WA = (const bf16_t*)(ws + OFF_WT_IN) + (size_t)6144 * DM; const float* SS0 = (const float*)(ws + OFF_RSTD);
    bf16_t* QD = (bf16_t*)(ws + OFF_QD); bf16_t* KTE = (bf16_t*)(ws + OFF_KTE); bf16_t* PSC = (bf16_t*)(ws + OFF_PSC); float* DEC = (float*)(ws + OFF_DEC);
    LAS bf16_t* sQ = (LAS bf16_t*)lds;
    LAS bf16_t* sK = sQ + 64 * 264;
    LAS float* sTot = (LAS float*)(lds + 2 * 64 * 264 * 2);
    LAS float* sAp = sTot + 512;
    LAS float* sAf = sAp + 2048;
    const int tid = threadIdx.x, kcol = tid & 255, half = __builtin_amdgcn_readfirstlane(tid >> 8);
    const int lane = tid & 63, wid = __builtin_amdgcn_readfirstlane(tid >> 6), fr = lane & 15, fq = lane >> 4;
    for (int item = blockIdx.x; item < 512; item += gridDim.x) {
        const int n = item & 63, h = (item >> 6) & 3, b = item >> 8;
        const int tok0 = b * SEQ + n * 64;
        {
            const int tt4 = wid & 3, kh = wid >> 2; f32x4 aacc = {0.f, 0.f, 0.f, 0.f};
            const bf16_t* arow = XB + (size_t)(tok0 + tt4 * 16 + fr) * DM + kh * 1024 + fq * 8;
            const bf16_t* brow = WA + (size_t)fr * DM + kh * 1024 + fq * 8;
            for (int kb0 = 0; kb0 < 32; kb0 += 16) {
                bf16x8 af[16], bfr[16];
#pragma unroll
                for (int i = 0; i < 16; ++i) { af[i] = *(const bf16x8*)(arow + (kb0 + i) * 32); bfr[i] = *(const bf16x8*)(brow + (kb0 + i) * 32); }
#pragma unroll
                for (int i = 0; i < 16; ++i) aacc = __builtin_amdgcn_mfma_f32_16x16x32_bf16(af[i], bfr[i], aacc, 0, 0, 0);
            }
#pragma unroll
            for (int j = 0; j < 4; ++j) sAp[kh * 1024 + (tt4 * 16 + 4 * fq + j) * 16 + fr] = aacc[j];
            __syncthreads();
#pragma unroll
            for (int q = 0; q < 2; ++q) { const int idx = tid + 512 * q; sAf[idx] = (sAp[idx] + sAp[1024 + idx]) * rsqrtf(SS0[tok0 + (idx >> 4)] * (1.f / 2048.f) + 1e-6f); }
            __syncthreads();
        }
        bf16_t qraw[32], kraw[32];
#pragma unroll
        for (int tt = 0; tt < 32; ++tt) { const size_t tok = (size_t)(tok0 + half * 32 + tt); qraw[tt] = __builtin_nontemporal_load(PROJ + tok * 6144 + h * 256 + kcol); kraw[tt] = __builtin_nontemporal_load(PROJ + tok * 6144 + 1024 + h * 256 + kcol); }
        float w2[16];
#pragma unroll
        for (int j = 0; j < 16; ++j) w2[j] = p.gla_w_a2[j * 1024 + h * 256 + kcol];
        const float bias = p.gla_b_a2[h * 256 + kcol];
        float cum[32]; float run = 0.f;
#pragma unroll
        for (int tt = 0; tt < 32; ++tt) {
            const LAS float* ap = sAf + (half * 32 + tt) * 16; float xg = bias;
#pragma unroll
            for (int j = 0; j < 16; ++j) xg += ap[j] * w2[j];
            const float ls = fminf(xg, 0.f) - __logf(1.f + __expf(-fabsf(xg)));
            run += ls * (1.f / 16.f); cum[tt] = run;
        }
        sTot[half * 256 + kcol] = run;
        __syncthreads();
        const float tot0 = sTot[kcol], tot1 = sTot[256 + kcol]; const float last = tot0 + tot1; const float off = half ? tot0 : 0.f;
        unsigned ktp[16];
#pragma unroll
        for (int tt = 0; tt < 32; ++tt) {
            const float c = cum[tt] + off; const int tok = tok0 + half * 32 + tt;
            const float q = bf2f(qraw[tt]); const float k = bf2f(kraw[tt]);
            const float qd = q * 0.0625f * __expf(c); const float ki = k * __expf(-c); const float kte = k * __expf(last - c);
            const bf16_t qb = f2bf(qd); QD[(((size_t)item * 8 + (kcol >> 5)) * 64 + half * 32 + tt) * 32 + (kcol & 31)] = qb;
            sQ[(half * 32 + tt) * 264 + kcol] = qb; sK[(half * 32 + tt) * 264 + kcol] = f2bf(ki);
            if (tt & 1) ktp[tt >> 1] |= ((unsigned)f2bf(kte)) << 16; else ktp[tt >> 1] = (unsigned)f2bf(kte);
        }
        {
            u32x4* dst = (u32x4*)(KTE + ((size_t)item * 256 + kcol) * 64 + half * 32);
#pragma unroll
            for (int i = 0; i < 4; ++i) { u32x4 vv = {ktp[4 * i], ktp[4 * i + 1], ktp[4 * i + 2], ktp[4 * i + 3]}; dst[i] = vv; }
        }
        if (half == 0) DEC[item * 256 + kcol] = __expf(last);
        __syncthreads();
        const int ttile = wid >> 1;
#pragma unroll
        for (int i = 0; i < 2; ++i) {
            const int st = (wid & 1) * 2 + i; f32x4 acc = {0.f, 0.f, 0.f, 0.f};
#pragma unroll
            for (int kb = 0; kb < 8; ++kb) {
                const bf16x8 a = *(const LAS bf16x8*)(sK + (st * 16 + fr) * 264 + kb * 32 + fq * 8);
                const bf16x8 bq = *(const LAS bf16x8*)(sQ + (ttile * 16 + fr) * 264 + kb * 32 + fq * 8);
                acc = __builtin_amdgcn_mfma_f32_16x16x32_bf16(a, bq, acc, 0, 0, 0);
            }
            const int t = ttile * 16 + fr, s0 = st * 16 + 4 * fq;
            const float v0 = (s0 + 0 <= t) ? acc[0] : 0.f, v1 = (s0 + 1 <= t) ? acc[1] : 0.f, v2 = (s0 + 2 <= t) ? acc[2] : 0.f, v3 = (s0 + 3 <= t) ? acc[3] : 0.f;
            u32x2 pk = {pack2(v0, v1), pack2(v2, v3)};
            *(u32x2*)(PSC + (((size_t)item * 2 + (s0 >> 5)) * 64 + t) * 32 + (s0 & 31)) = pk;
        }
        __syncthreads();
    }
}

__device__ __forceinline__ void gla_scan(const P& p, LAS unsigned char* lds, const int mode = 3) {
    unsigned char* ws = p.ws;
    const bf16_t* PROJ = (const bf16_t*)(ws + OFF_R1);
    const bf16_t* QD = (const bf16_t*)(ws + OFF_QD); const bf16_t* KTE = (const bf16_t*)(ws + OFF_KTE); const bf16_t* PSC = (const bf16_t*)(ws + OFF_PSC); const float* DEC = (const float*)(ws + OFF_DEC);
    float* OGLA = (float*)(ws + OFF_OGLA);
    LAS bf16_t* sVT = (LAS bf16_t*)lds;
    LAS bf16_t* sST = sVT + 32 * 72;
    LAS bf16_t* sT = (LAS bf16_t*)(lds + 24576);
    const int tid = threadIdx.x, lane = tid & 63, wid = __builtin_amdgcn_readfirstlane(tid >> 6), fr = lane & 15, fq = lane >> 4;
    const int n4 = tid & 15, kr = tid >> 4;
    const int bid = blockIdx.x; const bool split = (gridDim.x % 16 == 0);
    const int role = split ? ((bid >> 3) & 1) : 0; const int ridx = split ? (((bid >> 4) << 3) | (bid & 7)) : bid; const int nrole = split ? (int)gridDim.x / 2 : (int)gridDim.x;
    if (role == 0 && (mode & 1)) {
    const int sw = wid & 3;
    const int item0 = (gridDim.x == 256) ? ((bid & 7) * 16 + (bid >> 4)) : ridx;
    for (int item = item0; item < 128; item += nrole) {
        const int vs = item & 15, bh = item >> 4; const int h = bh & 3, b = bh >> 2;
        for (int i = tid; i < 32 * 264 / 2; i += 512) ((LAS unsigned*)sST)[i] = 0u;
        f32x4 S[2][4];
#pragma unroll
        for (int v = 0; v < 2; ++v)
#pragma unroll
            for (int i = 0; i < 4; ++i) S[v][i] = (f32x4){0.f, 0.f, 0.f, 0.f};
        u32x4 vrA = {0u, 0u, 0u, 0u}, vrB = {0u, 0u, 0u, 0u}; bf16x8 xfA[10], xfB[10]; float dA[4], dB[4];
#pragma unroll
        for (int k = 0; k < 10; ++k) { xfA[k] = (bf16x8){0, 0, 0, 0, 0, 0, 0, 0}; xfB[k] = xfA[k]; }
#pragma unroll
        for (int k = 0; k < 4; ++k) { dA[k] = 0.f; dB[k] = 0.f; }
#define GLA_LOAD(nn, VR, XF, DD) do { const int _tok0 = b * SEQ + (nn) * 64; const size_t _bhn = (size_t)bh * 64 + (nn); \
        if (tid < 256) VR = __builtin_nontemporal_load((const u32x4*)(PROJ + (size_t)(_tok0 + (tid >> 2)) * 6144 + 2048 + h * 512 + vs * 32 + (tid & 3) * 8)); \
        if (wid < 4) { \
            _Pragma("unroll") for (int _k = 0; _k < 8; ++_k) XF[_k] = *(const bf16x8*)(QD + ((_bhn * 8 + _k) * 64 + 16 * sw + fr) * 32 + fq * 8); \
            _Pragma("unroll") for (int _s = 0; _s < 2; ++_s) XF[8 + _s] = *(const bf16x8*)(PSC + ((_bhn * 2 + _s) * 64 + 16 * sw + fr) * 32 + fq * 8); \
        } else { \
            _Pragma("unroll") for (int _i = 0; _i < 4; ++_i) { _Pragma("unroll") for (int _t = 0; _t < 2; ++_t) XF[_i * 2 + _t] = *(const bf16x8*)(KTE + (_bhn * 256 + (4 * sw + _i) * 16 + fr) * 64 + _t * 32 + fq * 8); \
                DD[_i] = DEC[_bhn * 256 + (4 * sw + _i) * 16 + fr]; } } } while (0)
#define GLA_STEP(nn, VR, XF, DD, NEXTLOAD) do { \
        if (tid < 256) { const int _t = tid >> 2, _hv = tid & 3; \
            _Pragma("unroll") for (int _j = 0; _j < 4; ++_j) { sVT[(_hv * 8 + 2 * _j) * 72 + _t] = (bf16_t)(VR[_j] & 0xFFFFu); sVT[(_hv * 8 + 2 * _j + 1) * 72 + _t] = (bf16_t)(VR[_j] >> 16); } } \
        NEXTLOAD; \
        LDS_BARRIER(); \
        if (wid < 4) { \
            _Pragma("unroll") for (int _v = 0; _v < 2; ++_v) { f32x4 _a0 = {0.f, 0.f, 0.f, 0.f}, _a1 = {0.f, 0.f, 0.f, 0.f}; \
                _Pragma("unroll") for (int _sb = 0; _sb < 2; ++_sb) { const bf16x8 _a = *(const LAS bf16x8*)(sVT + (_v * 16 + fr) * 72 + _sb * 32 + fq * 8); if (_sb) _a1 = __builtin_amdgcn_mfma_f32_16x16x32_bf16(_a, XF[8 + _sb], _a1, 0, 0, 0); else _a0 = __builtin_amdgcn_mfma_f32_16x16x32_bf16(_a, XF[8 + _sb], _a0, 0, 0, 0); } \
                _Pragma("unroll") for (int _kb = 0; _kb < 8; ++_kb) { const bf16x8 _a = *(const LAS bf16x8*)(sST + (_v * 16 + fr) * 264 + _kb * 32 + fq * 8); if (_kb & 1) _a1 = __builtin_amdgcn_mfma_f32_16x16x32_bf16(_a, XF[_kb], _a1, 0, 0, 0); else _a0 = __builtin_amdgcn_mfma_f32_16x16x32_bf16(_a, XF[_kb], _a0, 0, 0, 0); } \
                *(f32x4*)(OGLA + (size_t)(b * SEQ + (nn) * 64 + 16 * sw + fr) * DM + h * 512 + vs * 32 + _v * 16 + 4 * fq) = _a0 + _a1; } \
        } else { \
            _Pragma("unroll") for (int _i = 0; _i < 4; ++_i) { S[0][_i] *= DD[_i]; S[1][_i] *= DD[_i]; } \
            _Pragma("unroll") for (int _tb = 0; _tb < 2; ++_tb) { const bf16x8 _a = *(const LAS bf16x8*)(sVT + fr * 72 + _tb * 32 + fq * 8); const bf16x8 _b = *(const LAS bf16x8*)(sVT + (16 + fr) * 72 + _tb * 32 + fq * 8); \
                _Pragma("unroll") for (int _i = 0; _i < 4; ++_i) { S[0][_i] = __builtin_amdgcn_mfma_f32_16x16x32_bf16(_a, XF[_i * 2 + _tb], S[0][_i], 0, 0, 0); S[1][_i] = __builtin_amdgcn_mfma_f32_16x16x32_bf16(_b, XF[_i * 2 + _tb], S[1][_i], 0, 0, 0); } } } \
        LDS_BARRIER(); \
        if (wid >= 4) { _Pragma("unroll") for (int _v = 0; _v < 2; ++_v) _Pragma("unroll") for (int _i = 0; _i < 4; ++_i) _Pragma("unroll") for (int _j = 0; _j < 4; ++_j) \
            sST[(_v * 16 + 4 * fq + _j) * 264 + (4 * sw + _i) * 16 + fr] = f2bf(S[_v][_i][_j]); } } while (0)
        GLA_LOAD(0, vrA, xfA, dA);
        for (int n = 0; n < 64; n += 2) {
            GLA_STEP(n, vrA, xfA, dA, GLA_LOAD(n + 1, vrB, xfB, dB));
            GLA_STEP(n + 1, vrB, xfB, dB, if (n + 2 < 64) GLA_LOAD(n + 2, vrA, xfA, dA));
        }
#undef GLA_LOAD
#undef GLA_STEP
        LDS_BARRIER();
    }
    }
    if ((role == 1 || !split) && (mode & 2)) {
        int cg_next = ridx; f32x4 cv[4][4]; float cgn[4][4]; bool c_have[4]; bf16_t* c_dst[4]; int c_K[4];
#pragma unroll
        for (int u = 0; u < 4; ++u) { c_have[u] = false; c_dst[u] = nullptr; c_K[u] = 0;
#pragma unroll
            for (int q = 0; q < 4; ++q) { cv[u][q] = (f32x4){0.f, 0.f, 0.f, 0.f}; cgn[u][q] = 1.f; } }
#define CONV_ISSUE_ALL() do { const float* _W = nullptr; const float* _gp = nullptr; bf16_t* _Wt = nullptr; int _ldw = 0, _K = 0, _bt = 0; \
        const bool _hv = (cg_next < CONV_BATCHES) && conv_locate(p, cg_next, _W, _ldw, _K, _gp, _Wt, _bt); cg_next += nrole; \
        _Pragma("unroll") for (int _u = 0; _u < 4; ++_u) c_have[_u] = _hv; \
        if (_hv) { const int _nb4cnt = conv_nb2(p, _W) >> 1; const int _kb = _bt / _nb4cnt, _nb4 = _bt - _kb * _nb4cnt;     \
            _Pragma("unroll") for (int _u = 0; _u < 4; ++_u) { const int _n0 = (4 * _nb4 + _u) * 64, _k0 = _kb * 128; c_K[_u] = _K; c_dst[_u] = _Wt + (size_t)_n0 * _K + _k0; \
                _Pragma("unroll") for (int _q = 0; _q < 4; ++_q) { const int _k = _k0 + 4 * kr + _q; cv[_u][_q] = __builtin_nontemporal_load((const f32x4*)(_W + (size_t)_k * _ldw + _n0 + n4 * 4)); cgn[_u][_q] = _gp ? _gp[_k] : 1.f; } } } } while (0)
        CONV_ISSUE_ALL();
        while (c_have[0]) {
            bf16_t* cd[4]; int cK[4]; bool ch[4];
#pragma unroll
            for (int u = 0; u < 4; ++u) { cd[u] = c_dst[u]; cK[u] = c_K[u]; ch[u] = c_have[u];
                if (ch[u]) {
#pragma unroll
                    for (int j = 0; j < 4; ++j) {
                        u32x2 pk = {pack2(cv[u][0][j] * cgn[u][0], cv[u][1][j] * cgn[u][1]), pack2(cv[u][2][j] * cgn[u][2], cv[u][3][j] * cgn[u][3])};
                        *(LAS u32x2*)(sT + u * (64 * 132) + (n4 * 4 + j) * 132 + 4 * kr) = pk;
                    }
                } }
            CONV_ISSUE_ALL();
            LDS_BARRIER();
#pragma unroll
            for (int u = 0; u < 4; ++u) if (ch[u]) {
#pragma unroll
                for (int q = 0; q < 2; ++q) { const int c = tid + 512 * q; const int n = c >> 4, kc = c & 15; const u32x2 d0 = *(const LAS u32x2*)(sT + u * (64 * 132) + n * 132 + kc * 8), d1 = *(const LAS u32x2*)(sT + u * (64 * 132) + n * 132 + kc * 8 + 4); const u32x4 dd = {d0[0], d0[1], d1[0], d1[1]}; __builtin_nontemporal_store(dd, (u32x4*)(cd[u] + (size_t)n * cK[u] + kc * 8)); }
            }
            LDS_BARRIER();
        }
#undef CONV_ISSUE_ALL
    }
}

__device__ __forceinline__ void gla_gate(const P& p) {
    unsigned char* ws = p.ws;
    const bf16_t* PROJ = (const bf16_t*)(ws + OFF_R1); const float* OGLA = (const float*)(ws + OFF_OGLA); bf16_t* OG = (bf16_t*)(ws + OFF_OG);
    const int lane = threadIdx.x & 63, wave = threadIdx.x >> 6;
    float hn[8];
#pragma unroll
    for (int j = 0; j < 8; ++j) hn[j] = p.gla_head_norm[lane * 8 + j];
    f32x4 no0 = {0.f, 0.f, 0.f, 0.f}, no1 = no0; u32x4 nrr = {0u, 0u, 0u, 0u};
#define GATE_LOAD(task_) do { const int _tok = (task_) >> 2, _h = (task_) & 3; const float* _op = OGLA + (size_t)_tok * DM + _h * 512 + lane * 8; \
        no0 = __builtin_nontemporal_load((const f32x4*)_op); no1 = __builtin_nontemporal_load((const f32x4*)(_op + 4)); nrr = __builtin_nontemporal_load((const u32x4*)(PROJ + (size_t)_tok * 6144 + 4096 + _h * 512 + lane * 8)); } while (0)
    const int task0 = blockIdx.x * 8 + wave, tstep = gridDim.x * 8;
    if (task0 < NTOK * 4) GATE_LOAD(task0);
    for (int task = task0; task < NTOK * 4; task += tstep) {
        const int tok = task >> 2, h = task & 3;
        const f32x4 o0 = no0, o1 = no1; const u32x4 rr = nrr;
        if (task + tstep < NTOK * 4) GATE_LOAD(task + tstep);
        float ss = o0[0] * o0[0] + o0[1] * o0[1] + o0[2] * o0[2] + o0[3] * o0[3] + o1[0] * o1[0] + o1[1] * o1[1] + o1[2] * o1[2] + o1[3] * o1[3];
        ss = wave_sum(ss);
        const float rs = rsqrtf(ss * (1.f / 512.f) + 1e-6f);
        float o[8] = {o0[0], o0[1], o0[2], o0[3], o1[0], o1[1], o1[2], o1[3]};
        float r[8] = {bflo(rr[0]), bfhi(rr[0]), bflo(rr[1]), bfhi(rr[1]), bflo(rr[2]), bfhi(rr[2]), bflo(rr[3]), bfhi(rr[3])};
        float y[8];
#pragma unroll
        for (int j = 0; j < 8; ++j) { const float sg = __fdividef(r[j], 1.f + __expf(-r[j])); y[j] = o[j] * rs * hn[j] * sg; }
        u32x4 pk = {pack2(y[0], y[1]), pack2(y[2], y[3]), pack2(y[4], y[5]), pack2(y[6], y[7])};
        *(u32x4*)(OG + (size_t)tok * DM + h * 512 + lane * 8) = pk;
    }
#undef GATE_LOAD
}

__device__ __forceinline__ float gelu_erf(float v) {
    const float av = fabsf(v), dd = av * 0.2316418882f + 1.0f;
    const float t = __builtin_amdgcn_rcpf(dd);
    float q = t * 0.5307027145f + (-0.7265760135f); q = q * t + 0.7107068705f; q = q * t + (-0.142248368f); q = q * t + 0.127414796f; q = q * t;
    const float e = __builtin_amdgcn_exp2f(v * v * (-0.72134752044f));
    const float mm = v * (q * e), rr = v - mm;
    return v < 0.f ? mm : rr;
}

__device__ __forceinline__ void convglu(const bf16_t* __restrict__ UG, bf16_t* __restrict__ ACT, const float* __restrict__ cw, const float* __restrict__ cb) {
    const int gtid = blockIdx.x * 512 + threadIdx.x, nth = gridDim.x * 512;
    for (int T = gtid; T < 512 * 704; T += nth) {
        const int run = T / 704, cgi = T - run * 704; const int c0 = cgi * 8, t0 = run * 16;
        float w0[8], w1[8], w2[8], bb[8], gm2[8], gm1[8];
#pragma unroll
        for (int j = 0; j < 8; ++j) { w0[j] = cw[c0 + j]; w1[j] = cw[DFF + c0 + j]; w2[j] = cw[2 * DFF + c0 + j]; bb[j] = cb[c0 + j]; gm2[j] = 0.f; gm1[j] = 0.f; }
        if ((t0 & (SEQ - 1)) != 0) {
            const u32x4 a = *(const u32x4*)(UG + (size_t)(t0 - 2) * (2 * DFF) + DFF + c0), c = *(const u32x4*)(UG + (size_t)(t0 - 1) * (2 * DFF) + DFF + c0);
#pragma unroll
            for (int j = 0; j < 4; ++j) { gm2[2 * j] = bflo(a[j]); gm2[2 * j + 1] = bfhi(a[j]); gm1[2 * j] = bflo(c[j]); gm1[2 * j + 1] = bfhi(c[j]); }
        }
#pragma unroll 4
        for (int tt = 0; tt < 16; ++tt) {
            const size_t tok = (size_t)(t0 + tt);
            const u32x4 gu = __builtin_nontemporal_load((const u32x4*)(UG + tok * (2 * DFF) + DFF + c0)), uu = __builtin_nontemporal_load((const u32x4*)(UG + tok * (2 * DFF) + c0));
            float gv[8], uv[8], y[8];
#pragma unroll
            for (int j = 0; j < 4; ++j) { gv[2 * j] = bflo(gu[j]); gv[2 * j + 1] = bfhi(gu[j]); uv[2 * j] = bflo(uu[j]); uv[2 * j + 1] = bfhi(uu[j]); }
#pragma unroll
            for (int j = 0; j < 8; ++j) { const float xv = w0[j] * gm2[j] + w1[j] * gm1[j] + w2[j] * gv[j] + bb[j]; y[j] = gelu_erf(xv) * uv[j]; gm2[j] = gm1[j]; gm1[j] = gv[j]; }
            u32x4 pk = {pack2(y[0], y[1]), pack2(y[2], y[3]), pack2(y[4], y[5]), pack2(y[6], y[7])};
            *(u32x4*)(ACT + tok * DFF + c0) = pk;
        }
    }
}

__device__ __forceinline__ void attn_phase(const P& p, LAS unsigned char* lds) {
    unsigned char* ws = p.ws;
    const bf16_t* KVQ = (const bf16_t*)(ws + OFF_R1); bf16_t* ATTO = (bf16_t*)(ws + OFF_ATTO); float* LSE = (float*)(ws + OFF_LSE);
    LAS bf16_t* sK = (LAS bf16_t*)lds;
    LAS bf16_t* sV = sK + 256 * 136;
    const int tid = threadIdx.x, lane = tid & 63, wid = __builtin_amdgcn_readfirstlane(tid >> 6), fr = lane & 15, fq = lane >> 4;
    const int ch = tid & 15, r0 = tid >> 4;
    u32x4 kk[8], vv[8]; bf16x8 qn[4];
#define ATT_DECODE(it, G, B_, H_, DL, QB, TB) const int G = (it) >> 10, B_ = ((it) >> 9) & 1, H_ = ((it) >> 5) & 15, DL = 2 * G; const int QB = ((it) & 31) & ((32 >> DL) - 1); const int TB = B_ * SEQ + (((it) & 31) >> (5 - DL));
#define ATT_LOADK(it) do { ATT_DECODE(it, _g, _b, _h, _dl, _qb, _tb) \
        _Pragma("unroll") for (int _ps = 0; _ps < 8; ++_ps) { const int _ik = (_qb - 1) * 128 + _ps * 32 + r0; \
            if (_ik >= 0) kk[_ps] = *(const u32x4*)(KVQ + (size_t)(_tb + (_ik << _dl)) * 10240 + _h * 128 + ch * 8); else kk[_ps] = (u32x4){0u, 0u, 0u, 0u}; } \
        { const bf16_t* _qs = KVQ + (size_t)(_tb + ((_qb * 128 + 16 * wid + fr) << _dl)) * 10240 + 4096 + _g * 2048 + _h * 128; \
          _Pragma("unroll") for (int _eb = 0; _eb < 4; ++_eb) qn[_eb] = __builtin_nontemporal_load((const bf16x8*)(_qs + _eb * 32 + fq * 8)); } } while (0)
#define ATT_LOADV(it) do { ATT_DECODE(it, _g, _b, _h, _dl, _qb, _tb) \
        _Pragma("unroll") for (int _ps = 0; _ps < 8; ++_ps) { const int _ik = (_qb - 1) * 128 + _ps * 32 + r0; \
            if (_ik >= 0) vv[_ps] = *(const u32x4*)(KVQ + (size_t)(_tb + (_ik << _dl)) * 10240 + 2048 + _h * 128 + ch * 8); else vv[_ps] = (u32x4){0u, 0u, 0u, 0u}; } } while (0)
    const bool xmap = (gridDim.x == 256); const int xcd = (int)blockIdx.x & 7, cu = (int)blockIdx.x >> 3;
    const int nsteps = xmap ? 12 : (((int)blockIdx.x < 3072) ? (3072 - 1 - (int)blockIdx.x) / (int)gridDim.x + 1 : 0);
#define ATT_ITEM(s) (xmap ? ((((((s) % 3) * 2 + ((xcd * 4 + (s) / 3) >> 4)) * 16 + ((xcd * 4 + (s) / 3) & 15)) * 32) + cu) : ((int)blockIdx.x + (s) * (int)gridDim.x))
    if (nsteps > 0) { const int it0 = ATT_ITEM(0); ATT_LOADK(it0); }
    for (int st = 0; st < nsteps; ++st) {
        const int item = ATT_ITEM(st); const int item_next = (st + 1 < nsteps) ? ATT_ITEM(st + 1) : -1;
        ATT_DECODE(item, g, b, h, dl, qb, tokbase)
#pragma unroll
        for (int ps = 0; ps < 8; ++ps) *(LAS u32x4*)(sK + (ps * 32 + r0) * 136 + ch * 8) = kk[ps];
        bf16x8 qf[4];
#pragma unroll
        for (int eb = 0; eb < 4; ++eb) qf[eb] = qn[eb];
        ATT_LOADV(item);
        LDS_BARRIER();
        const int iq = qb * 128 + 16 * wid + fr; const int tokq = tokbase + (iq << dl);
        f32x4 sc[9];
#pragma unroll
        for (int i = 0; i < 9; ++i) {
            f32x4 acc = {0.f, 0.f, 0.f, 0.f};
#pragma unroll
            for (int eb = 0; eb < 4; ++eb) { const bf16x8 a = *(const LAS bf16x8*)(sK + ((wid + i) * 16 + fr) * 136 + eb * 32 + fq * 8); acc = __builtin_amdgcn_mfma_f32_16x16x32_bf16(a, qf[eb], acc, 0, 0, 0); }
            sc[i] = acc;
        }
        const float c1 = 0.08838834764831845f * 1.4426950408889634f;
        const float slope2 = exp2f(-0.5f * (float)(h + 1)) * 1.4426950408889634f * (float)(1 << dl);
        float mx = -INFINITY;
        const int dlt = fr - 4 * fq; const float b0 = -slope2 * (float)(128 + dlt);
#pragma unroll
        for (int i = 0; i < 9; ++i) {
            const bool tile_ok = (qb > 0) || (wid + i >= 8);
#pragma unroll
            for (int j = 0; j < 4; ++j) {
                bool valid = tile_ok;
                if (i == 0) valid = valid && (dlt - j <= 0);
                if (i == 8) valid = valid && (dlt - j >= 0);
                const float sv = fmaf(sc[i][j], c1, b0 + slope2 * (float)(16 * i + j));
                const float s = valid ? sv : -INFINITY; sc[i][j] = s; mx = fmaxf(mx, s);
            }
        }
        mx = fmaxf(mx, __shfl_xor(mx, 16)); mx = fmaxf(mx, __shfl_xor(mx, 32));
        float lsum = 0.f;
#pragma unroll
        for (int i = 0; i < 9; ++i)
#pragma unroll
            for (int j = 0; j < 4; ++j) { const float pv = __builtin_amdgcn_exp2f(sc[i][j] - mx); sc[i][j] = pv; lsum += pv; }
        lsum += __shfl_xor(lsum, 16); lsum += __shfl_xor(lsum, 32);
#pragma unroll
        for (int ps = 0; ps < 8; ++ps) *(LAS u32x4*)(sV + (ps * 32 + r0) * 144 + ch * 8) = vv[ps];
        if (item_next >= 0) ATT_LOADK(item_next);
        LDS_BARRIER();
        f32x4 O[8];
#pragma unroll
        for (int et = 0; et < 8; ++et) O[et] = (f32x4){0.f, 0.f, 0.f, 0.f};
        const int q4 = (lane & 15) >> 2, p4 = lane & 3;
#pragma unroll
        for (int pr = 0; pr < 5; ++pr) {
            const int i0 = 2 * pr, i1 = (2 * pr + 1 < 9) ? 2 * pr + 1 : 2 * pr;
            u32x4 pbu;
            pbu[0] = pack2(sc[i0][0], sc[i0][1]); pbu[1] = pack2(sc[i0][2], sc[i0][3]);
            if (2 * pr + 1 < 9) { pbu[2] = pack2(sc[i1][0], sc[i1][1]); pbu[3] = pack2(sc[i1][2], sc[i1][3]); } else { pbu[2] = 0u; pbu[3] = 0u; }
            bf16x8 pb; { union { u32x4 u; bf16x8 s; } cv; cv.u = pbu; pb = cv.s; }
            const int row0 = (wid + i0) * 16 + 4 * fq + q4, row1 = (wid + i1) * 16 + 4 * fq + q4;
#pragma unroll
            for (int et = 0; et < 8; ++et) {
                const s16x4 lo = __builtin_amdgcn_ds_read_tr16_b64_v4i16((LAS s16x4*)(sV + row0 * 144 + et * 16 + 4 * p4));
                const s16x4 hi = __builtin_amdgcn_ds_read_tr16_b64_v4i16((LAS s16x4*)(sV + row1 * 144 + et * 16 + 4 * p4));
                const bf16x8 a = {lo[0], lo[1], lo[2], lo[3], hi[0], hi[1], hi[2], hi[3]};
                O[et] = __builtin_amdgcn_mfma_f32_16x16x32_bf16(a, pb, O[et], 0, 0, 0);
            }
        }
        const float inv = 1.f / lsum;
        bf16_t* od = ATTO + ((size_t)g * NTOK + tokq) * DM + h * 128 + 4 * fq;
#pragma unroll
        for (int et = 0; et < 8; ++et) { u32x2 pk = {pack2(O[et][0] * inv, O[et][1] * inv), pack2(O[et][2] * inv, O[et][3] * inv)}; *(u32x2*)(od + et * 16) = pk; }
        if (fq == 0) LSE[((size_t)g * NTOK + tokq) * 16 + h] = (mx + log2f(lsum)) * 0.6931471805599453f;
    }
    LDS_BARRIER();
#undef ATT_ITEM
#undef ATT_LOADK
#undef ATT_LOADV
#undef ATT_DECODE
}

__device__ __forceinline__ void attn_merge(const P& p) {
    unsigned char* ws = p.ws;
    const bf16_t* ATTO = (const bf16_t*)(ws + OFF_ATTO); const float* LSE = (const float*)(ws + OFF_LSE); bf16_t* OG = (bf16_t*)(ws + OFF_OG);
    const int gtid = blockIdx.x * 512 + threadIdx.x, nth = gridDim.x * 512;
    float nl0 = 0.f, nl1 = 0.f, nl2 = 0.f; u32x4 na = {0u, 0u, 0u, 0u}, nb = na, nc = na;
#define MERGE_LOAD(T_) do { const int _tok = (T_) >> 8, _ch = (T_) & 255, _h = _ch >> 4; \
        nl0 = LSE[(size_t)_tok * 16 + _h]; nl1 = LSE[((size_t)NTOK + _tok) * 16 + _h]; nl2 = LSE[((size_t)2 * NTOK + _tok) * 16 + _h]; \
        na = __builtin_nontemporal_load((const u32x4*)(ATTO + (size_t)_tok * DM + _ch * 8)); nb = __builtin_nontemporal_load((const u32x4*)(ATTO + ((size_t)NTOK + _tok) * DM + _ch * 8)); nc = __builtin_nontemporal_load((const u32x4*)(ATTO + ((size_t)2 * NTOK + _tok) * DM + _ch * 8)); } while (0)
    if (gtid < NTOK * 256) MERGE_LOAD(gtid);
    for (int T = gtid; T < NTOK * 256; T += nth) {
        const int tok = T >> 8, ch = T & 255;
        const float l0 = nl0, l1 = nl1, l2 = nl2; const u32x4 a = na, bq = nb, c = nc;
        if (T + nth < NTOK * 256) MERGE_LOAD(T + nth);
        const float m = fmaxf(l0, fmaxf(l1, l2)); float w0 = __expf(l0 - m), w1 = __expf(l1 - m), w2 = __expf(l2 - m); const float inv = __fdividef(1.f, w0 + w1 + w2); w0 *= inv; w1 *= inv; w2 *= inv;
        u32x4 pk;
#pragma unroll
        for (int j = 0; j < 4; ++j) pk[j] = pack2(w0 * bflo(a[j]) + w1 * bflo(bq[j]) + w2 * bflo(c[j]), w0 * bfhi(a[j]) + w1 * bfhi(bq[j]) + w2 * bfhi(c[j]));
        *(u32x4*)(OG + (size_t)tok * DM + ch * 8) = pk;
    }
#undef MERGE_LOAD
}

constexpr int N_PHASES = 17;
__device__ __forceinline__ void run_gemm_scale(const P& p, LAS unsigned char* lds, size_t offA, size_t offB, int N, int K, bf16_t* O, int ldo, const float* rstd, int nvalid, float* aout) {
    pg8::Gemm g{(const bf16_t*)(p.ws + offA), (const bf16_t*)(p.ws + offB), NTOK, N, K};
    pg8::StaticOrder S; S.init(NTOK, N, gridDim.x, blockIdx.x);
    EpiScaleBf16 E{O, ldo, rstd, nvalid, aout};
    pg8::gemm_phase<EpiScaleBf16, pg8::StaticOrder, true, true>(lds, g, S, E);
}
template <bool BASE_BF16> __device__ __forceinline__ void run_gemm_resid(const P& p, LAS unsigned char* lds, size_t offA, size_t offB, int K, const void* base, float* out) {
    pg8::Gemm g{(const bf16_t*)(p.ws + offA), (const bf16_t*)(p.ws + offB), NTOK, DM, K};
    pg8::StaticOrder S; S.init(NTOK, DM, gridDim.x, blockIdx.x);
    EpiResid<BASE_BF16> E{base, out};
    pg8::gemm_phase<EpiResid<BASE_BF16>, pg8::StaticOrder, true, true>(lds, g, S, E);
}
template <bool BASE_BF16> __device__ __forceinline__ void run_gemm_resid_norm(const P& p, LAS unsigned char* lds, size_t offA, size_t offB, int K, const void* base, float* sumsq) {
    pg8::Gemm g{(const bf16_t*)(p.ws + offA), (const bf16_t*)(p.ws + offB), NTOK, DM, K};
    pg8::StaticOrder S; S.init(NTOK, DM, gridDim.x, blockIdx.x);
    EpiResidNorm<BASE_BF16> E{base, (bf16_t*)(p.ws + OFF_XB), sumsq};
    pg8::gemm_phase<EpiResidNorm<BASE_BF16>, pg8::StaticOrder, true, true>(lds, g, S, E);
}
__global__ void __launch_bounds__(512, 2) mk_fwd(P p) {
    extern __shared__ __attribute__((aligned(16))) unsigned char lds_raw[];
    LAS unsigned char* lds = (LAS unsigned char*)lds_raw;
    unsigned char* ws = p.ws;
    float* RSTD = (float*)(ws + OFF_RSTD);
    float* H = p.out;
#ifndef PHMASK
#define PHMASK 0xFFFFF
#endif
    const int lo = p.ph_lo, hi = p.ph_hi;
    volatile LAS unsigned* xst = (volatile LAS unsigned*)(lds + LDS_BYTES - 16);
    if (threadIdx.x < 4) xst[threadIdx.x] = 0u;
    __syncthreads();
    XcdBarrier xb; xb.bar = (unsigned*)(ws + OFF_BAR); xb.x = 0; xb.st = xst;
    if (hi - lo > 1) xb = xcd_barrier_post((unsigned*)(ws + OFF_BAR), xst);
#define GRID_SEAM(k) do { if (p.ph_hi > 1000) { __syncthreads(); cg::this_grid().sync(); } xcd_barrier(xb); } while (0)
#ifndef PHDUP
#define PHDUP 0x0
#endif
#define PHASE(k, body) if (((PHMASK >> (k)) & 1) && lo <= (k) && (k) < hi) { if ((PHDUP >> (k)) & 1) { body; xcd_barrier(xb); } body; if ((k) + 1 < hi) GRID_SEAM(k); }
#ifdef PROBE_SYNCS
    if (hi - lo > 1) { for (int i = 0; i < PROBE_SYNCS; ++i) xcd_barrier(xb); }
#endif
    PHASE(0, phase_prologue(p, lds))
    PHASE(1, run_gemm_scale(p, lds, OFF_XB, OFF_WT_IN, 6144, DM, (bf16_t*)(ws + OFF_R1), 6144, RSTD, 6144, nullptr))
    PHASE(2, gla_prep(p, lds))
#ifdef PROBE_SCANMODE
    if (hi - lo > 1) { gla_scan(p, lds, PROBE_SCANMODE); xcd_barrier(xb); }
#endif
    PHASE(3, gla_scan(p, lds))
    PHASE(4, gla_gate(p))
    PHASE(5, run_gemm_resid_norm<false>(p, lds, OFF_OG, OFF_WT_GOUT, DM, p.x, RSTD + NTOK))
#ifdef PROBE_NULLGEMM
    if (hi - lo > 1) { pg8::Gemm g{(const bf16_t*)(p.ws + OFF_XB), (const bf16_t*)(p.ws + OFF_WT_UP0), NTOK, 2 * DFF, DM}; pg8::StaticOrder S; S.init(NTOK, 2 * DFF, gridDim.x, blockIdx.x); EpiNull E{(float*)(ws + OFF_AG)}; pg8::gemm_phase<EpiNull, pg8::StaticOrder, true, true>(lds, g, S, E); xcd_barrier(xb); }
#endif
    PHASE(6, run_gemm_scale(p, lds, OFF_XB, OFF_WT_UP0, 2 * DFF, DM, (bf16_t*)(ws + OFF_R1), 2 * DFF, RSTD + NTOK, 2 * DFF, nullptr))
    PHASE(7, convglu((const bf16_t*)(ws + OFF_R1), (bf16_t*)(ws + OFF_ACT), p.ffn_conv_w, p.ffn_conv_b))
    PHASE(8, run_gemm_resid_norm<true>(p, lds, OFF_ACT, OFF_WT_DN0, DFF, ws + OFF_XB, RSTD + 2 * NTOK))
    PHASE(9, run_gemm_scale(p, lds, OFF_XB, OFF_WT_KVQ, 10240, DM, (bf16_t*)(ws + OFF_R1), 10240, RSTD + 2 * NTOK, 10240, nullptr))
    PHASE(10, attn_phase(p, lds))
    PHASE(11, attn_merge(p))
    PHASE(12, run_gemm_resid_norm<true>(p, lds, OFF_OG, OFF_WT_AOUT, DM, ws + OFF_XB, RSTD + 3 * NTOK))
    PHASE(13, run_gemm_scale(p, lds, OFF_XB, OFF_WT_UP1, 2 * DFF, DM, (bf16_t*)(ws + OFF_R1), 2 * DFF, RSTD + 3 * NTOK, 2 * DFF, nullptr))
    PHASE(14, convglu((const bf16_t*)(ws + OFF_R1), (bf16_t*)(ws + OFF_ACT), p.ffn_conv_w + 3 * DFF, p.ffn_conv_b + DFF))
    PHASE(15, run_gemm_resid<true>(p, lds, OFF_ACT, OFF_WT_DN1, DFF, ws + OFF_XB, H))
    PHASE(16, final_norm_pass(H, p.final_norm))
}

extern "C" void kernel_launch(void* const* d_in, const int* in_sizes, int n_in, void* d_out, int out_size, void* d_ws, size_t ws_size, hipStream_t stream) {
    static int grid = 0;
    if (grid == 0) {
        if (n_in != 17 || out_size != NTOK * DM || ws_size < WS_END) { fprintf(stderr, "kernel_launch: unexpected shapes (n_in %d out %d ws %zu need %zu)\n", n_in, out_size, ws_size, (size_t)WS_END); grid = -1; return; }
        int dev = 0, cus = 0, per_cu = 0;
        hipGetDevice(&dev);
        hipDeviceGetAttribute(&cus, hipDeviceAttributeMultiprocessorCount, dev);
        if (hipFuncSetAttribute((const void*)mk_fwd, hipFuncAttributeMaxDynamicSharedMemorySize, LDS_BYTES) != hipSuccess) { fprintf(stderr, "kernel_launch: hipFuncSetAttribute failed\n"); grid = -1; return; }
        if (hipOccupancyMaxActiveBlocksPerMultiprocessor(&per_cu, (const void*)mk_fwd, 512, LDS_BYTES) != hipSuccess || per_cu < 1) { fprintf(stderr, "kernel_launch: occupancy query says %d\n", per_cu); per_cu = 1; }
        (void)hipGetLastError();
        grid = cus * 1;
        if (grid <= 0) grid = 256;
    }
    if (grid < 0) return;
    P p{};
    p.x = (const float*)d_in[0]; p.attn_norm = (const float*)d_in[1]; p.gla_w_in = (const float*)d_in[2]; p.gla_w_a2 = (const float*)d_in[3]; p.gla_b_a2 = (const float*)d_in[4];
    p.gla_head_norm = (const float*)d_in[5]; p.gla_w_out = (const float*)d_in[6]; p.kv_norm = (const float*)d_in[7]; p.w_kv = (const float*)d_in[8]; p.dsa_w_q = (const float*)d_in[9];
    p.dsa_w_out = (const float*)d_in[10]; p.ffn_norm = (const float*)d_in[11]; p.ffn_w_up = (const float*)d_in[12]; p.ffn_conv_w = (const float*)d_in[13]; p.ffn_conv_b = (const float*)d_in[14];
    p.ffn_w_down = (const float*)d_in[15]; p.final_norm = (const float*)d_in[16];
    p.out = (float*)d_out; p.ws = (unsigned char*)d_ws;
#if MK_ONE_LAUNCH
    if (hipMemsetAsync((char*)d_ws + OFF_BAR, 0, XCD_BAR_WORDS * 4, stream) != hipSuccess) { fprintf(stderr, "kernel_launch: memset of barrier words failed\n"); return; }
    p.ph_lo = 0; p.ph_hi = N_PHASES;
    void* args[] = {&p};
    hipError_t e = hipLaunchCooperativeKernel((const void*)mk_fwd, dim3(grid), dim3(512), args, LDS_BYTES, stream);
    if (e != hipSuccess) fprintf(stderr, "cooperative launch failed: %s (grid %d)\n", hipGetErrorString(e), grid);
#else
    for (int ph = 0; ph < N_PHASES; ++ph) {
        p.ph_lo = ph; p.ph_hi = ph + 1;
        hipLaunchKernelGGL(mk_fwd, dim3(grid), dim3(512), LDS_BYTES, stream, p);
    }
#endif
}
```
